# Optimizing an MI355X kernel written in HIP

```python
import math
import jax, jax.numpy as jnp
from jax import lax
import numpy as np

D_MODEL = 1024
BATCH = 8
SEQ = 2048
DEPTH = 2

BLOCK_Q = 128
DIFF_HEADS = 4
DIFF_QK_DIM = 32
DIFF_V_DIM = 64
FOX_HEADS = 6
FOX_HEAD_DIM = 64
MLA_HEADS = 6
MLA_Q_RANK = 256
MLA_KV_RANK = 128
MLA_NOPE_DIM = 64
MLA_ROPE_DIM = 32
MLA_V_DIM = 64
ROPE_THETA = 10000.0
REL_BUCKETS = 32
REL_MAX_DIST = 128
DIFF_WIDTH = DIFF_HEADS * DIFF_V_DIM
FOX_WIDTH = FOX_HEADS * FOX_HEAD_DIM
MLA_WIDTH = MLA_HEADS * MLA_V_DIM
MIX_WIDTH = DIFF_WIDTH + FOX_WIDTH + MLA_WIDTH
IN_SIZES = (
    DIFF_HEADS * 2 * DIFF_QK_DIM,
    DIFF_HEADS * 2 * DIFF_QK_DIM,
    DIFF_WIDTH,
    FOX_WIDTH,
    FOX_WIDTH,
    FOX_WIDTH,
    FOX_HEADS,
    MLA_Q_RANK,
    MLA_KV_RANK,
    MLA_ROPE_DIM,
)
IN_WIDTH = sum(IN_SIZES)
IN_OFFSETS = tuple(int(o) for o in np.cumsum(IN_SIZES)[:-1])
D_FF_DENSE = 2816
N_EXPERTS = 8
TOP_K = 2
D_FF_EXPERT = 3584
N_DENSE = (DEPTH + 1) // 2
N_MOE = DEPTH // 2
NORM_EPS = 1e-6

kernel_name = "hymba_style_diff_fox_mla_moe_trunk"


def _rmsnorm(x, g):
    xf = x.astype(jnp.float32)
    y = xf * lax.rsqrt(jnp.mean(xf * xf, axis=-1, keepdims=True) + NORM_EPS)
    return (y * g.astype(jnp.float32)).astype(x.dtype)


def _sweep(block_fn, seq):
    return jnp.concatenate([block_fn(i * BLOCK_Q, (i + 1) * BLOCK_Q) for i in range(seq // BLOCK_Q)], axis=1)


def _rel_dist(q0, q1):
    return (q0 + jnp.arange(q1 - q0))[:, None] - jnp.arange(q1)[None, :]


def _causal_softmax(logits, n):
    logits = jnp.where(n >= 0, logits, -jnp.inf)
    return jax.nn.softmax(logits, axis=-1)


def _t5_bucket(n):
    max_exact = REL_BUCKETS // 2
    n = jnp.maximum(n, 0)
    nf = jnp.maximum(n, 1).astype(jnp.float32)
    large = max_exact + (jnp.log(nf / max_exact) / math.log(REL_MAX_DIST / max_exact)
                         * (REL_BUCKETS - max_exact)).astype(jnp.int32)
    large = jnp.minimum(large, REL_BUCKETS - 1)
    return jnp.where(n < max_exact, n, large)


def _rope_tables(seq):
    half = MLA_ROPE_DIM // 2
    freqs = ROPE_THETA ** (-jnp.arange(half, dtype=jnp.float32) / half)
    ang = jnp.arange(seq, dtype=jnp.float32)[:, None] * freqs[None, :]
    return jnp.cos(ang), jnp.sin(ang)


def _rope(x, cos, sin):
    x1, x2 = jnp.split(x, 2, axis=-1)
    cs, sn = cos[:, None, :], sin[:, None, :]
    return jnp.concatenate([x1 * cs - x2 * sn, x1 * sn + x2 * cs], axis=-1).astype(x.dtype)


def _lambda_init(layer_idx):
    return 0.8 - 0.6 * math.exp(-0.3 * layer_idx)


def _diff_attention(q, k, v, diff_lambda, subln_g, rel_bias, lam_init):
    B, S = q.shape[0], q.shape[1]
    scale = DIFF_QK_DIM ** -0.5
    lam_p = diff_lambda.astype(jnp.float32)
    lam = jnp.exp(jnp.sum(lam_p[0] * lam_p[1])) - jnp.exp(jnp.sum(lam_p[2] * lam_p[3])) + lam_init

    def block(q0, q1):
        n = _rel_dist(q0, q1)
        logits = jnp.einsum('btmhd,bsmhd->bhmts',
                            jnp.swapaxes(q[:, q0:q1], 2, 3), jnp.swapaxes(k[:, :q1], 2, 3)).astype(jnp.float32) * scale
        bias = jnp.transpose(rel_bias[_t5_bucket(n)], (2, 0, 1)).astype(jnp.float32)
        p = _causal_softmax(logits + bias[None, :, None], n)
        w = p[:, :, 0] - lam * p[:, :, 1]
        return jnp.einsum('bhts,bshd->bthd', w.astype(v.dtype), v[:, :q1])

    o = _sweep(block, S)
    o = _rmsnorm(o, subln_g) * (1.0 - lam_init)
    return o.reshape(B, S, DIFF_WIDTH)


def _forgetting_attention(q, k, v, f_logit):
    B, S = q.shape[0], q.shape[1]
    scale = FOX_HEAD_DIM ** -0.5
    log_f = jax.nn.log_sigmoid(f_logit.astype(jnp.float32))
    F = jnp.transpose(jnp.cumsum(log_f, axis=1), (0, 2, 1))

    def block(q0, q1):
        n = _rel_dist(q0, q1)
        logits = jnp.einsum('bthd,bshd->bhts', q[:, q0:q1], k[:, :q1]).astype(jnp.float32) * scale
        decay = F[:, :, q0:q1, None] - F[:, :, None, :q1]
        p = _causal_softmax(logits + decay, n)
        return jnp.einsum('bhts,bshd->bthd', p.astype(v.dtype), v[:, :q1])

    return _sweep(block, S).reshape(B, S, FOX_WIDTH)


def _latent_attention(cq, ckv, kr, q_norm_g, kv_norm_g, w_uq, w_ukv, cos, sin):
    B, S = cq.shape[0], cq.shape[1]
    scale = (MLA_NOPE_DIM + MLA_ROPE_DIM) ** -0.5
    q = (_rmsnorm(cq, q_norm_g) @ w_uq).reshape(B, S, MLA_HEADS, MLA_NOPE_DIM + MLA_ROPE_DIM)
    q_nope, q_rope = q[..., :MLA_NOPE_DIM], _rope(q[..., MLA_NOPE_DIM:], cos, sin)
    kv = (_rmsnorm(ckv, kv_norm_g) @ w_ukv).reshape(B, S, MLA_HEADS, MLA_NOPE_DIM + MLA_V_DIM)
    k_nope, v = kv[..., :MLA_NOPE_DIM], kv[..., MLA_NOPE_DIM:]
    k_rope = _rope(kr[:, :, None, :], cos, sin)[:, :, 0]

    def block(q0, q1):
        n = _rel_dist(q0, q1)
        logits = (jnp.einsum('bthd,bshd->bhts', q_nope[:, q0:q1], k_nope[:, :q1])
                  + jnp.einsum('bthr,bsr->bhts', q_rope[:, q0:q1], k_rope[:, :q1])).astype(jnp.float32) * scale
        p = _causal_softmax(logits, n)
        return jnp.einsum('bhts,bshd->bthd', p.astype(v.dtype), v[:, :q1])

    return _sweep(block, S).reshape(B, S, MLA_WIDTH)


def _token_mixer(h, w_in, b_forget, diff_lambda, diff_subln, rel_bias, mla_q_norm, mla_kv_norm,
                 w_uq, w_ukv, w_out, cos, sin, lam_init):
    B, S, _ = h.shape
    proj = h @ w_in
    dq, dk, dv, fq, fk, fv, ff, cq, ckv, kr = jnp.split(proj, IN_OFFSETS, axis=-1)
    diff_out = _diff_attention(dq.reshape(B, S, DIFF_HEADS, 2, DIFF_QK_DIM),
                               dk.reshape(B, S, DIFF_HEADS, 2, DIFF_QK_DIM),
                               dv.reshape(B, S, DIFF_HEADS, DIFF_V_DIM),
                               diff_lambda, diff_subln, rel_bias, lam_init)
    fox_out = _forgetting_attention(fq.reshape(B, S, FOX_HEADS, FOX_HEAD_DIM),
                                    fk.reshape(B, S, FOX_HEADS, FOX_HEAD_DIM),
                                    fv.reshape(B, S, FOX_HEADS, FOX_HEAD_DIM),
                                    ff + b_forget)
    mla_out = _latent_attention(cq, ckv, kr, mla_q_norm, mla_kv_norm, w_uq, w_ukv, cos, sin)
    merged = jnp.concatenate([diff_out, fox_out, mla_out], axis=-1)
    return merged @ w_out


def _swiglu(h, w_gate, w_up, w_down):
    return (jax.nn.silu(h @ w_gate) * (h @ w_up)) @ w_down


def _moe(h, router_w, w_gate, w_up, w_down):
    B, S, D = h.shape
    t = h.reshape(B * S, D)
    logits = (t @ router_w).astype(jnp.float32)
    top_val, top_idx = lax.top_k(logits, TOP_K)
    top_w = jax.nn.softmax(top_val, axis=-1)
    combine = jnp.sum(jax.nn.one_hot(top_idx, N_EXPERTS, dtype=jnp.float32) * top_w[..., None], axis=1)
    y = jnp.zeros_like(t)
    for e in range(N_EXPERTS):
        y = y + combine[:, e:e + 1].astype(t.dtype) * _swiglu(t, w_gate[e], w_up[e], w_down[e])
    return y.reshape(B, S, D)


def setup_inputs(seed: int = 0) -> dict:
    key = jax.random.key(seed)
    ks = jax.random.split(key, 24)
    f32 = jnp.float32

    def nrm(k, shape, scale):
        return jax.random.normal(k, shape, f32) * scale

    def gain(k, shape):
        return 1.0 + 0.02 * jax.random.normal(k, shape, f32)

    D = D_MODEL
    return {
        "x": nrm(ks[0], (BATCH, SEQ, D), 1.0),
        "c": nrm(ks[1], (BATCH, D), 1.0),
        "w_ada": nrm(ks[2], (DEPTH, D, 6 * D), 0.5 * D ** -0.5),
        "b_ada": nrm(ks[3], (DEPTH, 6 * D), 0.02),
        "attn_norm": gain(ks[4], (DEPTH, D)),
        "ffn_norm": gain(ks[5], (DEPTH, D)),
        "w_in": nrm(ks[6], (DEPTH, D, IN_WIDTH), D ** -0.5),
        "b_forget": jax.random.uniform(ks[7], (DEPTH, FOX_HEADS), f32, 1.0, 4.0),
        "diff_lambda": nrm(ks[8], (DEPTH, 4, DIFF_QK_DIM), 0.1),
        "diff_subln": gain(ks[9], (DEPTH, DIFF_V_DIM)),
        "rel_bias": nrm(ks[10], (REL_BUCKETS, DIFF_HEADS), 0.5),
        "mla_q_norm": gain(ks[11], (DEPTH, MLA_Q_RANK)),
        "mla_kv_norm": gain(ks[12], (DEPTH, MLA_KV_RANK)),
        "w_uq": nrm(ks[13], (DEPTH, MLA_Q_RANK, MLA_HEADS * (MLA_NOPE_DIM + MLA_ROPE_DIM)), MLA_Q_RANK ** -0.5),
        "w_ukv": nrm(ks[14], (DEPTH, MLA_KV_RANK, MLA_HEADS * (MLA_NOPE_DIM + MLA_V_DIM)), MLA_KV_RANK ** -0.5),
        "w_out": nrm(ks[15], (DEPTH, MIX_WIDTH, D), MIX_WIDTH ** -0.5),
        "ffn_w_gate": nrm(ks[16], (N_DENSE, D, D_FF_DENSE), D ** -0.5),
        "ffn_w_up": nrm(ks[17], (N_DENSE, D, D_FF_DENSE), D ** -0.5),
        "ffn_w_down": nrm(ks[18], (N_DENSE, D_FF_DENSE, D), D_FF_DENSE ** -0.5),
        "router_w": nrm(ks[19], (N_MOE, D, N_EXPERTS), D ** -0.5),
        "moe_w_gate": nrm(ks[20], (N_MOE, N_EXPERTS, D, D_FF_EXPERT), D ** -0.5),
        "moe_w_up": nrm(ks[21], (N_MOE, N_EXPERTS, D, D_FF_EXPERT), D ** -0.5),
        "moe_w_down": nrm(ks[22], (N_MOE, N_EXPERTS, D_FF_EXPERT, D), D_FF_EXPERT ** -0.5),
        "final_norm": gain(ks[23], (D,)),
    }


def reference(x, c, w_ada, b_ada, attn_norm, ffn_norm, w_in, b_forget, diff_lambda, diff_subln,
              rel_bias, mla_q_norm, mla_kv_norm, w_uq, w_ukv, w_out, ffn_w_gate, ffn_w_up,
              ffn_w_down, router_w, moe_w_gate, moe_w_up, moe_w_down, final_norm):
    S = x.shape[1]
    cos, sin = _rope_tables(S)
    c_act = jax.nn.silu(c)
    for l in range(DEPTH):
        mod = c_act @ w_ada[l] + b_ada[l]
        sh_a, sc_a, g_a, sh_f, sc_f, g_f = [m[:, None, :] for m in jnp.split(mod, 6, axis=-1)]
        h = _rmsnorm(x, attn_norm[l]) * (1.0 + sc_a) + sh_a
        mix = _token_mixer(h, w_in[l], b_forget[l], diff_lambda[l], diff_subln[l], rel_bias,
                           mla_q_norm[l], mla_kv_norm[l], w_uq[l], w_ukv[l], w_out[l],
                           cos, sin, _lambda_init(l))
        x = x + g_a * mix
        h = _rmsnorm(x, ffn_norm[l]) * (1.0 + sc_f) + sh_f
        i = l // 2
        if l % 2 == 0:
            y = _swiglu(h, ffn_w_gate[i], ffn_w_up[i], ffn_w_down[i])
        else:
            y = _moe(h, router_w[i], moe_w_gate[i], moe_w_up[i], moe_w_down[i])
        x = x + g_f * y
    return _rmsnorm(x, final_norm)
```

```cpp
#include <hip/hip_runtime.h>
#include <cstdio>
#include <cstdint>

#define LAS __attribute__((address_space(3)))
#define GAS __attribute__((address_space(1)))
typedef unsigned short bf16;
typedef short bf16x8 __attribute__((ext_vector_type(8)));
typedef short s16x4 __attribute__((ext_vector_type(4)));
typedef float f32x4 __attribute__((ext_vector_type(4)));
typedef float f32x2 __attribute__((ext_vector_type(2)));
typedef float f32x16 __attribute__((ext_vector_type(16)));
typedef unsigned u32x4 __attribute__((ext_vector_type(4)));
typedef unsigned u32x2 __attribute__((ext_vector_type(2)));
typedef int i32x4 __attribute__((ext_vector_type(4)));
typedef int i32x8 __attribute__((ext_vector_type(8)));
typedef unsigned char fp8;

#ifndef MK_MULTI
#define MK_MULTI 0
#endif

constexpr int DM = 1024, NB = 8, SEQ = 2048, T = NB * SEQ, DEPTH = 2;
constexpr int INW = 2342, NIN = 2560;
constexpr int FFD = 2816, NEXP = 8, FFE = 3584;
constexpr int NWAVES = 8, NTHREADS = 512;
constexpr float EPS = 1e-6f;
constexpr float LOG2E = 1.4426950408889634f;
constexpr float C_DIFF = 0.25503486164919736f;
constexpr float C_FOX = 0.18033688011112042f;
constexpr float C_MLA = 0.14724444602590306f;

constexpr size_t MiB = 1u << 20;
constexpr size_t WS_CTL = 0, CTL_ZERO_BYTES = 66 * 1024;
constexpr size_t WS_MOD = 1 * MiB;
constexpr size_t WS_COS = 1 * MiB + 512 * 1024;
constexpr size_t WS_SIN = WS_COS + 128 * 1024;
constexpr size_t WS_SSQ = 2 * MiB;
constexpr size_t WS_SSKV = WS_SSQ + 64 * 1024;
constexpr size_t WS_TW = WS_SSKV + 64 * 1024;
constexpr size_t WS_SSP = 3 * MiB;
constexpr size_t WS_FB = 3 * MiB;
constexpr size_t WS_PERM = 4 * MiB;
constexpr size_t WS_MODP = 5 * MiB;
constexpr size_t WS_WIN = 8 * MiB;
constexpr size_t WS_WOUT = 18 * MiB;
constexpr size_t WS_WUP = 22 * MiB;
constexpr size_t WS_WGU = 24 * MiB;
constexpr size_t WS_WDN = 35 * MiB;
constexpr size_t WS_MGU = 41 * MiB;
constexpr size_t WS_MDN = 97 * MiB;
constexpr size_t WS_H = 434 * MiB;
constexpr size_t WS_DQ = 241 * MiB, WS_DK = 249 * MiB, WS_DV = 257 * MiB;
constexpr size_t WS_FQ = 265 * MiB, WS_FK = 277 * MiB, WS_FV = 289 * MiB;
constexpr size_t WS_CQKV = 301 * MiB;
constexpr size_t WS_MISC = 317 * MiB;
constexpr size_t WS_MQ = 321 * MiB, WS_MK = 339 * MiB, WS_MV = 357 * MiB;
constexpr size_t WS_MERGED = 369 * MiB;
constexpr size_t WS_ACT = 125 * MiB;
constexpr size_t WS_ACT8 = 253 * MiB;
constexpr size_t WS_Y1 = 8 * MiB;
constexpr size_t WS_FK2 = 466 * MiB;
constexpr size_t WS_HS8 = 125 * MiB;
constexpr size_t WS_XR = 402 * MiB;
constexpr size_t WS_END = 482 * MiB;
constexpr int CW_TMO = 0, CW_BAR = 4096, CW_ATTQ = 8192, CW_CNT = 8448, CW_CONVQ = 16384;

constexpr int RING_BYTES = 131072;
constexpr int MISC_OFF = RING_BYTES;
constexpr int LDS_BYTES = 147456;

#define RLX_AGENT __ATOMIC_RELAXED, __HIP_MEMORY_SCOPE_AGENT
#define LDS_WAIT() asm volatile("s_waitcnt lgkmcnt(0)" ::: "memory")
#define VM_WAIT() asm volatile("s_waitcnt vmcnt(0)" ::: "memory")
__device__ __forceinline__ unsigned cvt_pk_bf16(float lo, float hi) { unsigned r; asm volatile("v_cvt_pk_bf16_f32 %0, %1, %2" : "=v"(r) : "v"(lo), "v"(hi)); return r; }
__device__ __forceinline__ float bf2f(bf16 v) { return __uint_as_float(((unsigned)v) << 16); }
__device__ __forceinline__ int lane_id() { int l; asm volatile("v_mbcnt_lo_u32_b32 %0, -1, 0\n\tv_mbcnt_hi_u32_b32 %0, -1, %0" : "=v"(l)); return l; }
template <int X> __device__ __forceinline__ float xor_lane(float v) {
    const int l = lane_id(); return __uint_as_float((unsigned)__builtin_amdgcn_ds_bpermute((l ^ X) << 2, (int)__float_as_uint(v)));
}
__device__ __forceinline__ float half_swap_sum(float v) { return v + xor_lane<32>(v); }
__device__ __forceinline__ float wave_sum(float v) {
    v += xor_lane<1>(v); v += xor_lane<2>(v); v += xor_lane<4>(v); v += xor_lane<8>(v); v += xor_lane<16>(v);
    return half_swap_sum(v);
}
__device__ __forceinline__ const void* uniform_ptr(const void* p) { const unsigned long long v = (unsigned long long)p;
    const unsigned lo = __builtin_amdgcn_readfirstlane((unsigned)v), hi = __builtin_amdgcn_readfirstlane((unsigned)(v >> 32)); return (const void*)(((unsigned long long)hi << 32) | lo); }
__device__ __forceinline__ void glds16(const void* sbase_, unsigned voff, unsigned lds_dst_) { unsigned keep; const void* sbase = uniform_ptr(sbase_); const unsigned lds_dst = __builtin_amdgcn_readfirstlane(lds_dst_);
    asm volatile("s_mov_b32 %0, m0\n\ts_mov_b32 m0, %3\n\ts_nop 0\n\tglobal_load_lds_dwordx4 %1, %2\n\ts_mov_b32 m0, %0" : "=&s"(keep) : "v"(voff), "s"(sbase), "s"(lds_dst) : "memory"); }
__device__ __forceinline__ void glds4(const void* sbase_, unsigned voff, unsigned lds_dst_) { unsigned keep; const void* sbase = uniform_ptr(sbase_); const unsigned lds_dst = __builtin_amdgcn_readfirstlane(lds_dst_);
    asm volatile("s_mov_b32 %0, m0\n\ts_mov_b32 m0, %3\n\ts_nop 0\n\tglobal_load_lds_dword %1, %2\n\ts_mov_b32 m0, %0" : "=&s"(keep) : "v"(voff), "s"(sbase), "s"(lds_dst) : "memory"); }
__device__ __forceinline__ int grid_n() { return __builtin_amdgcn_readfirstlane((int)gridDim.x); }
__device__ __forceinline__ int block_i() { return __builtin_amdgcn_readfirstlane((int)blockIdx.x); }
__device__ __forceinline__ f32x4 zero4_asm() { float a, b, c, d; asm volatile("v_mov_b32 %0, 0\n\tv_mov_b32 %1, 0\n\tv_mov_b32 %2, 0\n\tv_mov_b32 %3, 0" : "=v"(a), "=v"(b), "=v"(c), "=v"(d)); return (f32x4){a, b, c, d}; }
__device__ __forceinline__ f32x16 zero16_asm() { const f32x4 a = zero4_asm(), b = zero4_asm(), c = zero4_asm(), d = zero4_asm();
    return (f32x16){a[0], a[1], a[2], a[3], b[0], b[1], b[2], b[3], c[0], c[1], c[2], c[3], d[0], d[1], d[2], d[3]}; }
__device__ __forceinline__ u32x4 zero4u_asm() { return __builtin_bit_cast(u32x4, zero4_asm()); }
__device__ __forceinline__ float fexp2(float x) { return __builtin_amdgcn_exp2f(x); }
__device__ __forceinline__ float frcp(float x) { return __builtin_amdgcn_rcpf(x); }
__device__ __forceinline__ float silu_f(float g) { return g * frcp(1.f + fexp2(-g * LOG2E)); }

#define XB_TMO      128
#define XB_XCNT(j)  (256  + 64 * (j))
#define XB_XSUB(j)  (1280 + 64 * (j))
#define XB_XGEN(j)  (2304 + 64 * (j))
#define XB_TOP      3328
#define XB_TOPGEN   3392
#define XCD_BAR_WORDS 3456
#define XB_LSUB(j)  (3456 + 32 * (j))
#define XB_LGEN(j)  (3712 + 32 * (j))
#define XB_SPIN_CAP (1u << 18)
__device__ __forceinline__ unsigned xb_ld(unsigned* p)              { return __hip_atomic_load(p, __ATOMIC_RELAXED, __HIP_MEMORY_SCOPE_AGENT); }
__device__ __forceinline__ unsigned xb_add(unsigned* p, unsigned v) { return __hip_atomic_fetch_add(p, v, __ATOMIC_RELAXED, __HIP_MEMORY_SCOPE_AGENT); }
__device__ __forceinline__ unsigned xb_xcc_id() { return (unsigned)__builtin_amdgcn_s_getreg((3 << 11) | 20) & 0xFu; }
#define XB_SPIN(cond, bar) do { unsigned _sp = 0; while (cond) { __builtin_amdgcn_s_sleep(1); \
    if ((++_sp & 255u) == 0u) { if (xb_ld(&(bar)[XB_TMO])) break; if (_sp > XB_SPIN_CAP) { atomicAdd(&(bar)[XB_TMO], 1u); break; } } } } while (0)
struct XcdBarrier { unsigned* bar; unsigned x; volatile LAS unsigned* st; };
__device__ __forceinline__ void xcd_barrier_post(unsigned* bar, int wid, volatile LAS unsigned* st) {
    if (wid == 0 && lane_id() == 0) st[3] = xb_add(&bar[XB_XCNT(xb_xcc_id())], 1u);
}
__device__ __forceinline__ void xcd_barrier_complete(unsigned* bar, unsigned x, unsigned& nloc, unsigned& nx, unsigned& uni) {
    const unsigned G = (unsigned)grid_n();
    unsigned sum, cnt, mine, bad, sp = 0u;
    for (;;) {
        sum = 0u; cnt = 0u; mine = 0u; bad = 0u;
#pragma unroll
        for (unsigned j = 0; j < 16; ++j) { const unsigned c = xb_ld(&bar[XB_XCNT(j)]); sum += c; cnt += (c > 0u) ? 1u : 0u; mine = (j == x) ? c : mine; bad += (c != 0u && (c * 8u != G || j >= 8u)) ? 1u : 0u; }
        if (sum == G) break;
        __builtin_amdgcn_s_sleep(1);
        if ((++sp & 255u) == 0u) { if (xb_ld(&bar[XB_TMO])) break; if (sp > XB_SPIN_CAP) { atomicAdd(&bar[XB_TMO], 1u); break; } }
    }
    nloc = mine > 0u ? mine : 1u; nx = cnt > 0u ? cnt : 1u;
    uni = (sum == G && cnt == 8u && bad == 0u && G >= 64u) ? 1u : 0u;
}
__device__ __forceinline__ void xcd_barrier(unsigned* bar_, volatile LAS unsigned* st_, int wid) {
    XcdBarrier b; b.bar = bar_; b.x = xb_xcc_id(); b.st = st_;
    asm volatile("s_waitcnt vmcnt(0)" ::: "memory");
    __syncthreads();
    if (wid == 0 && lane_id() == 0) {
        unsigned* bar = b.bar;
        __builtin_amdgcn_s_waitcnt(0);
        unsigned nloc = b.st[0], nx = b.st[1];
        if (nloc == 0u) { unsigned uni = 0u; xcd_barrier_complete(bar, b.x, nloc, nx, uni); b.st[0] = nloc; b.st[1] = nx; b.st[2] = uni; }
        const unsigned old = xb_add(&bar[XB_XSUB(b.x)], 1u);
        const unsigned gen = old / nloc;
        if (old + 1u == (gen + 1u) * nloc) {
            __builtin_amdgcn_fence(__ATOMIC_RELEASE, "agent");
            asm volatile("s_waitcnt vmcnt(0)" ::: "memory");
            const unsigned og = xb_add(&bar[XB_TOP], 1u);
            const unsigned tg = og / nx;
            if (og + 1u == (tg + 1u) * nx) xb_add(&bar[XB_TOPGEN], 1u);
            else XB_SPIN(xb_ld(&bar[XB_TOPGEN]) == tg, bar);
            __builtin_amdgcn_fence(__ATOMIC_ACQUIRE, "agent");
            xb_add(&bar[XB_XGEN(b.x)], 1u);
            asm volatile("s_waitcnt vmcnt(0)" ::: "memory");
        } else {
            XB_SPIN(xb_ld(&bar[XB_XGEN(b.x)]) == gen, bar);
            __builtin_amdgcn_fence(__ATOMIC_ACQUIRE, "agent");
            asm volatile("s_waitcnt vmcnt(0)" ::: "memory");
        }
    }
    __syncthreads();
}

__device__ __forceinline__ void xcd_local_barrier(unsigned* bar_, volatile LAS unsigned* st_, int wid) {
    asm volatile("s_waitcnt vmcnt(0)" ::: "memory");
    __syncthreads();
    if (wid == 0 && lane_id() == 0) {
        unsigned* bar = bar_; const unsigned x = xb_xcc_id(); const unsigned nloc = st_[0];
        __builtin_amdgcn_s_waitcnt(0);
        const unsigned old = xb_add(&bar[XB_LSUB(x)], 1u);
        const unsigned gen = old / nloc;
        if (old + 1u == (gen + 1u) * nloc) xb_add(&bar[XB_LGEN(x)], 1u);
        else XB_SPIN(xb_ld(&bar[XB_LGEN(x)]) == gen, bar);
        __builtin_amdgcn_fence(__ATOMIC_ACQUIRE, "agent");
        asm volatile("s_waitcnt vmcnt(0)" ::: "memory");
    }
    __syncthreads();
}

__device__ __forceinline__ void xcd_local_arrive(unsigned* bar_, volatile LAS unsigned* st_, int wid) {
    asm volatile("s_waitcnt vmcnt(0)" ::: "memory");
    __syncthreads();
    if (wid == 0 && lane_id() == 0) {
        unsigned* bar = bar_; const unsigned x = xb_xcc_id(); const unsigned nloc = st_[0];
        __builtin_amdgcn_s_waitcnt(0);
        const unsigned old = xb_add(&bar[XB_LSUB(x)], 1u);
        const unsigned gen = old / nloc;
        st_[5] = gen;
        if (old + 1u == (gen + 1u) * nloc) xb_add(&bar[XB_LGEN(x)], 1u);
    }
}
__device__ __forceinline__ void xcd_local_wait(unsigned* bar_, volatile LAS unsigned* st_, int wid) {
    if (wid == 0 && lane_id() == 0) {
        unsigned* bar = bar_; const unsigned x = xb_xcc_id(); const unsigned gen = st_[5];
        XB_SPIN(xb_ld(&bar[XB_LGEN(x)]) == gen, bar);
        __builtin_amdgcn_fence(__ATOMIC_ACQUIRE, "agent");
        asm volatile("s_waitcnt vmcnt(0)" ::: "memory");
    }
    __syncthreads();
}

__device__ __forceinline__ void xcd_barrier_arrive(unsigned* bar_, volatile LAS unsigned* st_, int wid) {
    asm volatile("s_waitcnt vmcnt(0)" ::: "memory");
    __syncthreads();
    if (wid == 0 && lane_id() == 0) {
        unsigned* bar = bar_; const unsigned x = xb_xcc_id(); unsigned nloc = st_[0], nx = st_[1];
        __builtin_amdgcn_s_waitcnt(0);
        if (nloc == 0u) { unsigned uni = 0u; xcd_barrier_complete(bar, x, nloc, nx, uni); st_[0] = nloc; st_[1] = nx; st_[2] = uni; }
        const unsigned old = xb_add(&bar[XB_XSUB(x)], 1u);
        const unsigned gen = old / nloc; unsigned role = 0u, tg = 0u;
        if (old + 1u == (gen + 1u) * nloc) {
            __builtin_amdgcn_fence(__ATOMIC_RELEASE, "agent");
            asm volatile("s_waitcnt vmcnt(0)" ::: "memory");
            const unsigned og = xb_add(&bar[XB_TOP], 1u);
            tg = og / nx; role = 1u;
            if (og + 1u == (tg + 1u) * nx) { xb_add(&bar[XB_TOPGEN], 1u); role = 2u; }
        }
        st_[7] = gen; st_[8] = tg; st_[9] = role;
    }
}
__device__ __forceinline__ void xcd_barrier_wait(unsigned* bar_, volatile LAS unsigned* st_, int wid) {
    if (wid == 0 && lane_id() == 0) {
        unsigned* bar = bar_; const unsigned x = xb_xcc_id(); const unsigned gen = st_[7], tg = st_[8], role = st_[9];
        if (role != 0u) {
            if (role == 1u) XB_SPIN(xb_ld(&bar[XB_TOPGEN]) == tg, bar);
            __builtin_amdgcn_fence(__ATOMIC_ACQUIRE, "agent");
            xb_add(&bar[XB_XGEN(x)], 1u);
            asm volatile("s_waitcnt vmcnt(0)" ::: "memory");
        } else {
            XB_SPIN(xb_ld(&bar[XB_XGEN(x)]) == gen, bar);
            __builtin_amdgcn_fence(__ATOMIC_ACQUIRE, "agent");
            asm volatile("s_waitcnt vmcnt(0)" ::: "memory");
        }
    }
    __syncthreads();
}

namespace pg8 {
constexpr int BM = 256, BK = 64, HALF = 128, HTB = HALF * BK * 2, STAGE_BYTES = 8 * HTB, NXCD = 8, WGM = 8;
__host__ __device__ __forceinline__ int lds_byte(int r, int c) { const int st = (r >> 4) * 2 + (c >> 5), rr = r & 15, cc = c & 31, ob = rr * 64 + cc * 2; return st * 1024 + (ob ^ (((ob >> 9) & 1) << 5)); }
__host__ __device__ __forceinline__ void stage_rc(int b, int& R, int& C) { const int st = b / 1024, sb = b % 1024, swz = sb ^ (((sb >> 9) & 1) << 5); R = (st >> 1) * 16 + swz / 64; C = (st & 1) * 32 + (swz % 64) / 2; }
__host__ __device__ __forceinline__ int perm32(int rho) { const int n = rho >> 4, i = rho & 15; return 8 * (i >> 2) + 4 * n + (i & 3); }

struct Unit { int arow, acolb, brow, orow, pn, nvalid, aux; };
struct Gemm { const void* A; const void* Bt; int nt, ldaB, ldbB; const int* gidx; };

struct StaticOrder {
    int nM, nN, nwg, G, c, pm0, loc;
    __device__ void init(int npm, int pm0_, int N, int G_, int c_, int loc_) { nM = npm; nN = N / BM; nwg = nM * nN; G = G_; c = c_; pm0 = pm0_; loc = loc_; }
    __device__ bool next(int i, Unit& u) const {
        const long L = (long)i * G + c; if (L >= nwg) return false;
        int pm, pn;
        if (loc) { pn = (int)L / nM; pm = (int)L - pn * nM; }
        else { int wgid = (int)L; { const int q = nwg / NXCD, r = nwg % NXCD, xcd = wgid % NXCD, off = wgid / NXCD; wgid = (xcd < r ? xcd * (q + 1) : r * (q + 1) + (xcd - r) * q) + off; }
            const int nig = WGM * nN, gid = wgid / nig, fm = gid * WGM, gsz = (nM - fm) < WGM ? (nM - fm) : WGM;
            pm = fm + ((wgid % nig) % gsz); pn = (wgid % nig) / gsz; }
        pm += pm0;
        u.arow = pm * BM; u.acolb = 0; u.brow = pn * BM; u.orow = pm * BM; u.pn = pn; u.nvalid = BM; u.aux = 0; return true;
    }
};

template <class Epi, class Sched, bool GATHER, bool FP8 = false, int NB = 2>
__device__ __forceinline__ void gemm_phase(LAS unsigned char* lds_in, const Gemm g, const Sched& S, const Epi& E, int wid_in) {
    LAS unsigned char* lds = lds_in; int wid = wid_in; asm volatile("" : "+s"(lds), "+s"(wid));
    int lane_ = lane_id(); asm volatile("" : "+v"(lane_));
    const int lane = lane_, tid = wid * 64 + lane, wr = wid >> 2, wc = wid & 3, fr = lane & 15, fq = lane >> 4;
    const int nt = g.nt;
    unsigned voffA[2], voffB[2]; int RA[2]; unsigned CA2[2];
#pragma unroll
    for (int i = 0; i < 2; ++i) { int R, C; stage_rc(tid * 16 + i * 8192, R, C); const int Rb = Epi::PERM ? ((R & ~31) + perm32(R & 31)) : R;
        voffA[i] = (unsigned)(R * g.ldaB + C * 2); voffB[i] = (unsigned)(Rb * g.ldbB + C * 2); RA[i] = R; CA2[i] = (unsigned)C * 2u; }
    const size_t kstep = (size_t)(BK * 2);
    const size_t hstepA = (size_t)HALF * g.ldaB, hstepB = (size_t)HALF * g.ldbB;
    const unsigned ldsw = (unsigned)wid * 1024u, ldsbase = (unsigned)(uintptr_t)lds;
    const int aoff = lds_byte(wr * 64 + fr, fq * 8), boff = lds_byte(wc * 32 + fr, fq * 8);
#define PG8_SA(b, h) (((b) * 2 + (h)) * HTB)
#define PG8_SB(b, h) ((4 + (b) * 2 + (h)) * HTB)
#define PG8_STAGE(bufoff, gbase, voff) do { _Pragma("unroll") for (int _i = 0; _i < 2; ++_i) \
        glds16((const void*)(gbase), (voff)[_i], ldsbase + (unsigned)(bufoff) + ldsw + _i * 8192u); } while (0)
#define PG8_STAGE_A(bufoff, gbase, h, OFFS) do { if constexpr (GATHER) { unsigned go_[2]; _Pragma("unroll") for (int _j = 0; _j < 2; ++_j) go_[_j] = ((OFFS[_j] >> (16 * (h))) & 0xFFFFu) * (unsigned)g.ldaB + CA2[_j]; \
        PG8_STAGE(bufoff, gbase, go_); } else { PG8_STAGE(bufoff, (gbase) + (h) * hstepA, voffA); } } while (0)
#define PG8_LDA(dst, b, h) do { _Pragma("unroll") for (int m = 0; m < 4; ++m) _Pragma("unroll") for (int k = 0; k < 2; ++k) dst[m][k] = *(const LAS bf16x8*)(lds + PG8_SA(b, h) + aoff + m * 2048 + k * 1024); } while (0)
#define PG8_LDB(dst, b, h) do { _Pragma("unroll") for (int n = 0; n < 2; ++n) _Pragma("unroll") for (int k = 0; k < 2; ++k) dst[n][k] = *(const LAS bf16x8*)(lds + PG8_SB(b, h) + boff + n * 2048 + k * 1024); } while (0)
#define PG8_CAT(x0, x1) __builtin_shufflevector(__builtin_bit_cast(i32x4, x0), __builtin_bit_cast(i32x4, x1), 0, 1, 2, 3, 4, 5, 6, 7)
#define PG8_MMA(ai, bj, At, Bt) do { __builtin_amdgcn_s_setprio(1); \
        if constexpr (FP8) { _Pragma("unroll") for (int m = 0; m < 4; ++m) _Pragma("unroll") for (int n = 0; n < 2; ++n) \
            acc[ai][bj][m][n] = __builtin_amdgcn_mfma_scale_f32_16x16x128_f8f6f4(PG8_CAT(Bt[n][0], Bt[n][1]), PG8_CAT(At[m][0], At[m][1]), acc[ai][bj][m][n], 0, 0, 0, (int)Epi::SCALE_B, 0, 0x7F7F7F7F); } \
        else { _Pragma("unroll") for (int m = 0; m < 4; ++m) _Pragma("unroll") for (int n = 0; n < 2; ++n) _Pragma("unroll") for (int k = 0; k < 2; ++k) \
            acc[ai][bj][m][n] = __builtin_amdgcn_mfma_f32_16x16x32_bf16(Bt[n][k], At[m][k], acc[ai][bj][m][n], 0, 0, 0); } \
        __builtin_amdgcn_s_setprio(0); } while (0)
#define PG8_WAIT_V(n) asm volatile("s_waitcnt vmcnt(" #n ")" ::: "memory")
#define PG8_WAIT_L(n) asm volatile("s_waitcnt lgkmcnt(" #n ")" ::: "memory")
#define PG8_BAR __builtin_amdgcn_s_barrier()
#define PG8_SCHED __builtin_amdgcn_sched_barrier(0)
#define PG8_GOFF(dst, U) do { int t_ = tid; asm volatile("" : "+v"(t_)); unsigned _t[2][2]; const int nvm1_ = (U).nvalid - 1; \
        _Pragma("unroll") for (int _i = 0; _i < 2; ++_i) { int R_, C_; stage_rc(t_ * 16 + _i * 8192, R_, C_); \
            _Pragma("unroll") for (int _h = 0; _h < 2; ++_h) { const int _r = _h * HALF + R_; _t[_h][_i] = (unsigned)g.gidx[(U).arow + (_r < nvm1_ ? _r : nvm1_)]; } } \
        _Pragma("unroll") for (int _i = 0; _i < 2; ++_i) dst[_i] = (_t[0][_i] & 0xFFFFu) | (_t[1][_i] << 16); } while (0)
    Unit cur, nxt; int ui = 0;
    if (!S.next(0, cur)) return;
    f32x4 acc[2][2][4][2];
#pragma unroll
    for (int a = 0; a < 2; ++a)
#pragma unroll
        for (int b = 0; b < 2; ++b)
#pragma unroll
            for (int m = 0; m < 4; ++m)
#pragma unroll
                for (int n = 0; n < 2; ++n) acc[a][b][m][n] = (f32x4){0.f, 0.f, 0.f, 0.f};
    bf16x8 At[4][2], B0[2][2], B1[2][2];
    unsigned co[2], no[2], so[2];
#pragma unroll
    for (int i = 0; i < 2; ++i) { co[i] = 0u; no[i] = 0u; so[i] = 0u; }
    if constexpr (GATHER) { PG8_GOFF(co, cur); }
    const char* cA = GATHER ? ((const char*)g.A + cur.acolb) : ((const char*)g.A + (size_t)cur.arow * g.ldaB + cur.acolb);
    const char* cB = (const char*)g.Bt + (size_t)cur.brow * g.ldbB;
    PG8_STAGE(PG8_SB(0, 0), cB, voffB); PG8_STAGE(PG8_SB(0, 1), cB + hstepB, voffB); PG8_STAGE_A(PG8_SA(0, 0), cA, 0, co); PG8_STAGE_A(PG8_SA(0, 1), cA, 1, co);
    if (wr == 1) PG8_BAR;
    PG8_WAIT_V(2); PG8_BAR;
    PG8_STAGE(PG8_SB(1, 0), cB + kstep, voffB); PG8_STAGE_A(PG8_SA(1, 0), cA + kstep, 0, co); PG8_STAGE(PG8_SB(1, 1), cB + hstepB + kstep, voffB);
    PG8_WAIT_V(6); PG8_BAR;
    for (;;) {
        const bool has_next = S.next(ui + 1, nxt);
        const char* nA = cA; const char* nB = cB;
        if (has_next) { nA = GATHER ? ((const char*)g.A + nxt.acolb) : ((const char*)g.A + (size_t)nxt.arow * g.ldaB + nxt.acolb); nB = (const char*)g.Bt + (size_t)nxt.brow * g.ldbB; }
        if constexpr (GATHER) {
            if (has_next) { PG8_GOFF(no, nxt); }
            else { no[0] = co[0]; no[1] = co[1]; }
        }
        for (int t = 0; t < nt; t += 2) {
            const bool last = (t == nt - 2);
            const char* a1 = cA + (size_t)(t + 1) * kstep;
            const char* a2 = last ? nA : cA + (size_t)(t + 2) * kstep; const char* b2 = last ? nB : cB + (size_t)(t + 2) * kstep;
            const char* a3 = a2 + kstep; const char* b3 = b2 + kstep;
            if constexpr (GATHER) { so[0] = last ? no[0] : co[0]; so[1] = last ? no[1] : co[1]; }
            PG8_LDB(B0, 0, 0); if (NB == 2) PG8_LDB(B1, 0, 1); PG8_SCHED; PG8_LDA(At, 0, 0); PG8_STAGE_A(PG8_SA(1, 1), a1, 1, co);
            PG8_WAIT_V(8); PG8_WAIT_L(0); PG8_BAR; PG8_MMA(0, 0, At, B0); if (NB == 2) PG8_MMA(0, 1, At, B1); PG8_BAR; PG8_SCHED;
            PG8_LDA(At, 0, 1); PG8_STAGE(PG8_SB(0, 0), b2, voffB); PG8_STAGE(PG8_SB(0, 1), b2 + hstepB, voffB); PG8_STAGE_A(PG8_SA(0, 0), a2, 0, so);
            PG8_WAIT_V(8); PG8_WAIT_L(0); PG8_BAR; PG8_MMA(1, 0, At, B0); if (NB == 2) PG8_MMA(1, 1, At, B1); PG8_BAR; PG8_SCHED;
            PG8_LDB(B0, 1, 0); if (NB == 2) PG8_LDB(B1, 1, 1); PG8_SCHED; PG8_LDA(At, 1, 0); PG8_STAGE_A(PG8_SA(0, 1), a2, 1, so);
            PG8_WAIT_V(8); PG8_WAIT_L(0); PG8_BAR; PG8_MMA(0, 0, At, B0); if (NB == 2) PG8_MMA(0, 1, At, B1); PG8_BAR; PG8_SCHED;
            PG8_LDA(At, 1, 1); PG8_STAGE(PG8_SB(1, 0), b3, voffB); PG8_STAGE(PG8_SB(1, 1), b3 + hstepB, voffB); PG8_STAGE_A(PG8_SA(1, 0), a3, 0, so);
            PG8_WAIT_V(8); PG8_WAIT_L(0); PG8_BAR; PG8_MMA(1, 0, At, B0); if (NB == 2) PG8_MMA(1, 1, At, B1); PG8_BAR; PG8_SCHED;
        }
        if (wr == 0) PG8_BAR;
        { const int ln_ = lane_id();
          E(acc, cur, wr, wc, ln_ & 15, ln_ >> 4); }
        if (!has_next) break;
#pragma unroll
        for (int a = 0; a < 2; ++a)
#pragma unroll
            for (int b = 0; b < 2; ++b)
#pragma unroll
                for (int m = 0; m < 4; ++m)
#pragma unroll
                    for (int n = 0; n < 2; ++n) acc[a][b][m][n] = (f32x4){0.f, 0.f, 0.f, 0.f};
        cur = nxt; cA = nA; cB = nB; ++ui;
        if constexpr (GATHER) { co[0] = no[0]; co[1] = no[1]; }
        if (wr == 1) PG8_BAR;
    }
    PG8_WAIT_V(0);
    PG8_BAR;
#undef PG8_SA
#undef PG8_SB
#undef PG8_STAGE
#undef PG8_STAGE_A
#undef PG8_LDA
#undef PG8_LDB
#undef PG8_MMA
#undef PG8_CAT
#undef PG8_WAIT_V
#undef PG8_WAIT_L
#undef PG8_BAR
#undef PG8_SCHED
#undef PG8_GOFF
}
}
using pg8::Unit;

struct ColDesc { int mode; bf16* dst; int pitch; float scale; const float* rs; int nrs; float rsinv; float* ss; };

__device__ __forceinline__ ColDesc desc_in(int cg, unsigned char* ws) {
    ColDesc d; d.mode = 1; d.dst = nullptr; d.pitch = 0; d.scale = 1.f; d.rs = nullptr; d.nrs = 0; d.rsinv = 0.f; d.ss = nullptr;
    if (cg < 4)       { d.dst = (bf16*)(ws + WS_DQ) + cg * 64; d.pitch = 256; d.scale = C_DIFF; }
    else if (cg < 8)  { d.dst = (bf16*)(ws + WS_DK) + (cg - 4) * 64; d.pitch = 256; }
    else if (cg < 12) { d.dst = (bf16*)(ws + WS_DV) + (cg - 8) * 64; d.pitch = 256; }
    else if (cg < 18) { d.dst = (bf16*)(ws + WS_FQ) + (cg - 12) * 64; d.pitch = 384; d.scale = C_FOX; }
    else if (cg < 24) { d.dst = (bf16*)(ws + WS_FK2) + (cg - 18) * 80; d.pitch = 480; }
    else if (cg < 30) { d.dst = (bf16*)(ws + WS_FV) + (cg - 24) * 64; d.pitch = 384; }
    else if (cg < 34) { d.mode = 4; d.dst = (bf16*)(ws + WS_CQKV) + (cg - 30) * 64; d.pitch = 512; d.ss = (float*)(ws + WS_SSP) + (cg - 30) * 2; }
    else if (cg < 36) { d.mode = 4; d.dst = (bf16*)(ws + WS_CQKV) + 256 + (cg - 34) * 64; d.pitch = 512; d.ss = (float*)(ws + WS_SSP) + 8 + (cg - 34) * 2; }
    else if (cg == 36) { d.mode = 3; }
    else d.mode = 0;
    return d;
}
__device__ __forceinline__ ColDesc desc_up(int cg, unsigned char* ws) {
    ColDesc d; d.mode = 1; d.dst = nullptr; d.pitch = 0; d.scale = 1.f; d.rs = nullptr; d.nrs = 0; d.rsinv = 0.f; d.ss = nullptr;
    if (cg < 6)       { d.dst = (bf16*)(ws + WS_MQ) + cg * 96; d.pitch = 576; d.scale = C_MLA; d.rs = (const float*)(ws + WS_SSP); d.nrs = 8; d.rsinv = 1.f / 256.f; }
    else if (cg < 9)  { d.mode = 2; d.dst = (bf16*)(ws + WS_MQ) + (2 * (cg - 6)) * 96 + 64; d.pitch = 576; d.scale = C_MLA; d.rs = (const float*)(ws + WS_SSP); d.nrs = 8; d.rsinv = 1.f / 256.f; }
    else if (cg < 12) { d.mode = 0; }
    else if (cg < 18) { d.dst = (bf16*)(ws + WS_MK) + (cg - 12) * 96; d.pitch = 576; d.rs = (const float*)(ws + WS_SSP) + 8; d.nrs = 4; d.rsinv = 1.f / 128.f; }
    else              { d.dst = (bf16*)(ws + WS_MV) + (cg - 18) * 64; d.pitch = 384; d.rs = (const float*)(ws + WS_SSP) + 8; d.nrs = 4; d.rsinv = 1.f / 128.f; }
    return d;
}

template <int WHICH> struct EpiSplit {
    static constexpr bool PERM = true; static constexpr unsigned SCALE_B = 0x7F7F7F7Fu;
    unsigned char* ws;
    const LAS float* rsl;
    __device__ __forceinline__ void operator()(const f32x4 (&acc)[2][2][4][2], const Unit& u, int wr, int wc, int fr, int fq) const {
        const float* cosT = (const float*)(ws + WS_COS); const float* sinT = (const float*)(ws + WS_SIN);
#pragma unroll
        for (int bj = 0; bj < 2; ++bj) {
            const int cg = u.pn * 4 + bj * 2 + (wc >> 1);
            const ColDesc d = (WHICH == 0) ? desc_in(cg, ws) : desc_up(cg, ws);
            const int cin = (wc & 1) * 32 + 8 * fq;
            const int row0 = u.orow + wr * 64 + fr;
            if (d.mode == 1 || d.mode == 4) {
#pragma unroll
                for (int ai = 0; ai < 2; ++ai)
#pragma unroll
                    for (int m = 0; m < 4; ++m) {
                        const int row = row0 + ai * 128 + m * 16;
                        float s = d.scale; if (d.rs) { s *= rsl[(wr * 64 + fr + ai * 128 + m * 16) * 2 + (d.nrs == 8 ? 0 : 1)]; }
                        const f32x4 v0 = acc[ai][bj][m][0] * s, v1 = acc[ai][bj][m][1] * s;
                        u32x4 w; w.x = cvt_pk_bf16(v0[0], v0[1]); w.y = cvt_pk_bf16(v0[2], v0[3]); w.z = cvt_pk_bf16(v1[0], v1[1]); w.w = cvt_pk_bf16(v1[2], v1[3]);
                        *(u32x4*)(d.dst + (size_t)row * d.pitch + cin) = w;
                        if (d.mode == 4) {
                            float q = (v0[0] * v0[0] + v0[1] * v0[1]) + (v0[2] * v0[2] + v0[3] * v0[3]) + (v1[0] * v1[0] + v1[1] * v1[1]) + (v1[2] * v1[2] + v1[3] * v1[3]);
                            q += xor_lane<16>(q); q = half_swap_sum(q);
                            if (fq == 0) d.ss[(size_t)row * 12 + (wc & 1)] = q;
                        }
                        if (WHICH == 0 || m == 3) asm volatile("" ::: "memory");
                    }
            } else if (d.mode == 2) {
                bf16* dst = d.dst + (wc & 1) * 96;
#pragma unroll
                for (int ai = 0; ai < 2; ++ai)
#pragma unroll
                    for (int m = 0; m < 4; ++m) {
                        const int row = row0 + ai * 128 + m * 16; const int pos = row & (SEQ - 1);
                        const float s = d.scale * rsl[(wr * 64 + fr + ai * 128 + m * 16) * 2];
                        const f32x4 cs = *(const f32x4*)(cosT + pos * 16 + 4 * fq), sn = *(const f32x4*)(sinT + pos * 16 + 4 * fq);
                        const f32x4 x1 = acc[ai][bj][m][0], x2 = acc[ai][bj][m][1];
                        const f32x4 o1 = (x1 * cs - x2 * sn) * s, o2 = (x1 * sn + x2 * cs) * s;
                        u32x2 w1, w2; w1.x = cvt_pk_bf16(o1[0], o1[1]); w1.y = cvt_pk_bf16(o1[2], o1[3]); w2.x = cvt_pk_bf16(o2[0], o2[1]); w2.y = cvt_pk_bf16(o2[2], o2[3]);
                        *(u32x2*)(dst + (size_t)row * d.pitch + 4 * fq) = w1;
                        *(u32x2*)(dst + (size_t)row * d.pitch + 16 + 4 * fq) = w2;
                        if (WHICH == 0 || m == 3) asm volatile("" ::: "memory");
                    }
            } else if (d.mode == 3) {
                float* dst = (float*)(ws + WS_MISC);
#pragma unroll
                for (int ai = 0; ai < 2; ++ai)
#pragma unroll
                    for (int m = 0; m < 4; ++m) {
                        const int row = row0 + ai * 128 + m * 16;
                        *(f32x4*)(dst + (size_t)row * 64 + cin) = acc[ai][bj][m][0];
                        *(f32x4*)(dst + (size_t)row * 64 + cin + 4) = acc[ai][bj][m][1];
                    }
            }
        }
    }
};

struct EpiGU {
    static constexpr bool PERM = true; static constexpr unsigned SCALE_B = 0x7F7F7F7Fu;
    bf16* act; int ldc;
    __device__ __forceinline__ void operator()(const f32x4 (&acc)[2][2][4][2], const Unit& u, int wr, int wc, int fr, int fq) const {
        const int col = u.pn * 128 + wc * 32 + 8 * fq;
#pragma unroll
        for (int ai = 0; ai < 2; ++ai)
#pragma unroll
            for (int m = 0; m < 4; ++m) {
                const int rl = ai * 128 + wr * 64 + m * 16 + fr;
                const f32x4 g0 = acc[ai][0][m][0], g1 = acc[ai][0][m][1], u0 = acc[ai][1][m][0], u1 = acc[ai][1][m][1];
                float o[8];
#pragma unroll
                for (int j = 0; j < 4; ++j) { o[j] = fexp2(g0[j] * -LOG2E); o[4 + j] = fexp2(g1[j] * -LOG2E); }
#pragma unroll
                for (int j = 0; j < 8; ++j) o[j] = frcp(1.f + o[j]);
#pragma unroll
                for (int j = 0; j < 4; ++j) { o[j] = (g0[j] * u0[j]) * o[j]; o[4 + j] = (g1[j] * u1[j]) * o[4 + j]; }
                u32x4 w; w.x = cvt_pk_bf16(o[0], o[1]); w.y = cvt_pk_bf16(o[2], o[3]); w.z = cvt_pk_bf16(o[4], o[5]); w.w = cvt_pk_bf16(o[6], o[7]);
                if (rl < u.nvalid) *(u32x4*)(act + (size_t)(u.orow + rl) * ldc + col) = w;
            }
    }
};

__device__ __forceinline__ unsigned pk4_fp8(float a, float b, float c, float d) { int w = 0; w = __builtin_amdgcn_cvt_pk_fp8_f32(a, b, w, false); w = __builtin_amdgcn_cvt_pk_fp8_f32(c, d, w, true); return (unsigned)w; }
struct EpiGU8 {
    static constexpr bool PERM = true; static constexpr unsigned SCALE_B = 0x79797979u;
    fp8* act; int ldc;
    __device__ __forceinline__ void operator()(const f32x4 (&acc)[2][2][4][2], const Unit& u, int wr, int wc, int fr, int fq) const {
        const int col = u.pn * 128 + wc * 32 + 8 * fq;
#pragma unroll
        for (int ai = 0; ai < 2; ++ai)
#pragma unroll
            for (int m = 0; m < 4; ++m) {
                const int rl = ai * 128 + wr * 64 + m * 16 + fr;
                const f32x4 g0 = acc[ai][0][m][0], g1 = acc[ai][0][m][1], u0 = acc[ai][1][m][0], u1 = acc[ai][1][m][1];
                float o[8];
#pragma unroll
                for (int j = 0; j < 4; ++j) { o[j] = fexp2(g0[j] * -LOG2E); o[4 + j] = fexp2(g1[j] * -LOG2E); }
#pragma unroll
                for (int j = 0; j < 8; ++j) o[j] = frcp(1.f + o[j]);
#pragma unroll
                for (int j = 0; j < 4; ++j) { o[j] = (g0[j] * u0[j]) * o[j]; o[4 + j] = (g1[j] * u1[j]) * o[4 + j]; }
                u32x2 w; w.x = pk4_fp8(o[0], o[1], o[2], o[3]); w.y = pk4_fp8(o[4], o[5], o[6], o[7]);
                if (rl < u.nvalid) *(u32x2*)(act + (size_t)(u.orow + rl) * ldc + col) = w;
            }
    }
};

struct EpiResid {
    static constexpr bool PERM = true; static constexpr unsigned SCALE_B = 0x7F7F7F7Fu;
    const float* xin32; const bf16* xin16; bf16* xout; const float* gate;
    __device__ __forceinline__ void operator()(const f32x4 (&acc)[2][2][4][2], const Unit& u, int wr, int wc, int fr, int fq) const {
        const int b = u.orow / SEQ; const float* gv = gate + (size_t)b * 6144;
#pragma unroll
        for (int bj = 0; bj < 2; ++bj) {
            const int col = u.pn * 256 + bj * 128 + wc * 32 + 8 * fq;
            const f32x4 g0 = *(const f32x4*)(gv + col), g1 = *(const f32x4*)(gv + col + 4);
#pragma unroll
            for (int ai = 0; ai < 2; ++ai)
#pragma unroll
                for (int m = 0; m < 4; ++m) {
                    const size_t off = (size_t)(u.orow + ai * 128 + wr * 64 + m * 16 + fr) * DM + col;
                    f32x4 x0, x1;
                    if (xin32) { x0 = *(const f32x4*)(xin32 + off); x1 = *(const f32x4*)(xin32 + off + 4); }
                    else { const u32x4 y = *(const u32x4*)(xin16 + off);
                        x0 = (f32x4){__uint_as_float(y.x << 16), __uint_as_float(y.x & 0xFFFF0000u), __uint_as_float(y.y << 16), __uint_as_float(y.y & 0xFFFF0000u)};
                        x1 = (f32x4){__uint_as_float(y.z << 16), __uint_as_float(y.z & 0xFFFF0000u), __uint_as_float(y.w << 16), __uint_as_float(y.w & 0xFFFF0000u)}; }
                    const f32x4 o0 = x0 + g0 * acc[ai][bj][m][0], o1 = x1 + g1 * acc[ai][bj][m][1];
                    u32x4 w; w.x = cvt_pk_bf16(o0[0], o0[1]); w.y = cvt_pk_bf16(o0[2], o0[3]); w.z = cvt_pk_bf16(o1[0], o1[1]); w.w = cvt_pk_bf16(o1[2], o1[3]);
                    *(u32x4*)(xout + off) = w;
                    if (m == 3) asm volatile("" ::: "memory");
                }
        }
    }
};

template <int NB> struct EpiMoeDownT {
    static constexpr bool PERM = true; static constexpr unsigned SCALE_B = 0x79797979u;
    bf16* x; bf16* y1; const float* gate; const int* perm; const float* tw;
    __device__ __forceinline__ void operator()(const f32x4 (&acc)[2][2][4][2], const Unit& u, int wr, int wc, int fr, int fq) const {
        const int* pl = perm + u.aux;
        int tok[8]; unsigned s1m[8]; float wgt[8];
#pragma unroll
        for (int i = 0; i < 8; ++i) { const int rl = (i >> 2) * 128 + wr * 64 + (i & 3) * 16 + fr; const int ent = pl[rl < u.nvalid ? rl : u.nvalid - 1]; tok[i] = ent & 0xFFFF; s1m[i] = (unsigned)(ent >> 16); }
#pragma unroll
        for (int i = 0; i < 8; ++i) wgt[i] = tw[tok[i] * 2 + (int)s1m[i]];
        asm volatile("" ::: "memory");
#pragma unroll
        for (int bj = 0; bj < NB; ++bj) {
            const int col = (NB == 2 ? u.pn * 256 + bj * 128 : u.pn * 128) + wc * 32 + 8 * fq;
#pragma unroll
            for (int hf = 0; hf < 2; ++hf) {
                f32x4 ga[4], gb[4]; u32x4 y[4]; bf16* p[4];
#pragma unroll
                for (int m = 0; m < 4; ++m) { const int i = hf * 4 + m; const float* gv = gate + (size_t)(tok[i] / SEQ) * 6144 + col;
                    p[m] = (s1m[i] ? y1 : x) + (size_t)tok[i] * DM + col; ga[m] = *(const f32x4*)gv; gb[m] = *(const f32x4*)(gv + 4); y[m] = *(const u32x4*)p[m]; }
#pragma unroll
                for (int m = 0; m < 4; ++m) { const int i = hf * 4 + m; const int rl = hf * 128 + wr * 64 + m * 16 + fr;
                    const f32x4 v0 = ga[m] * acc[hf][bj][m][0] * wgt[i], v1 = gb[m] * acc[hf][bj][m][1] * wgt[i];
                    const unsigned km = s1m[i] ? 0u : 0xFFFFFFFFu;
                    const u32x4 yy = (u32x4){y[m].x & km, y[m].y & km, y[m].z & km, y[m].w & km};
                    const f32x4 o0 = (f32x4){__uint_as_float(yy.x << 16), __uint_as_float(yy.x & 0xFFFF0000u), __uint_as_float(yy.y << 16), __uint_as_float(yy.y & 0xFFFF0000u)} + v0;
                    const f32x4 o1 = (f32x4){__uint_as_float(yy.z << 16), __uint_as_float(yy.z & 0xFFFF0000u), __uint_as_float(yy.w << 16), __uint_as_float(yy.w & 0xFFFF0000u)} + v1;
                    u32x4 w; w.x = cvt_pk_bf16(o0[0], o0[1]); w.y = cvt_pk_bf16(o0[2], o0[3]); w.z = cvt_pk_bf16(o1[0], o1[1]); w.w = cvt_pk_bf16(o1[2], o1[3]);
                    if (rl < u.nvalid) *(u32x4*)p[m] = w; }
                asm volatile("" ::: "memory");
            }
        }
    }
};
typedef EpiMoeDownT<2> EpiMoeDown;

struct MoeOrder {
    const volatile LAS int* tab; int G, c, NPN, kind, lim;
    __device__ bool next(int i, Unit& u) const {
#define TABU(k) __builtin_amdgcn_readfirstlane(tab[k])
        int L = i * G + c; const int total = TABU(32); int half = 0;
        if (kind == 2) { if (L >= 2 * (total - lim)) return false; half = L & 1; L = lim + (L >> 1); }
        else if (L >= (total < lim ? total : lim)) return false;
        int e = 0;
#pragma unroll
        for (int k = 1; k < 8; ++k) e += (L >= TABU(24 + k)) ? 1 : 0;
        const int rem = L - TABU(24 + e), ntm = TABU(16 + e), cnt = TABU(e), base = TABU(8 + e);
        const int pn = __builtin_amdgcn_readfirstlane(rem / ntm), mt = rem - pn * ntm;
#undef TABU
        const int nv = cnt - mt * 256;
#define RFL(x) __builtin_amdgcn_readfirstlane(x)
        u.nvalid = RFL(nv < 256 ? nv : 256); u.pn = RFL(pn); u.acolb = 0;
        u.aux = RFL(e * T + mt * 256);
        if (kind == 0) { u.arow = RFL(e * T + mt * 256); u.brow = RFL(e * (2 * FFE) + pn * 256); u.orow = RFL(base + mt * 256); }
        else if (kind == 1) { u.arow = RFL(base + mt * 256);  u.brow = RFL(e * DM + pn * 256);        u.orow = 0; }
        else           { u.arow = RFL(base + mt * 256);  u.brow = RFL(e * DM + pn * 256 + half * 128); u.pn = RFL(pn * 2 + half); u.orow = 0; }
#undef RFL
        return true;
    }
};
__device__ __forceinline__ void moe_tables(volatile LAS int* tab, const unsigned* cntw, int npn, int wid) {
    if (wid == 0) {
        const int ln = lane_id();
        int c = 0;
        if (ln < 8) c = (int)__hip_atomic_load(cntw + 64 * ln, RLX_AGENT);
        const int ntm = (c + 255) >> 8, nu = ntm * npn;
        int b = c, up = nu;
#pragma unroll
        for (int o = 1; o < 8; o <<= 1) {
            const int tb = __builtin_amdgcn_ds_bpermute(((ln - o) & 63) << 2, b), tu = __builtin_amdgcn_ds_bpermute(((ln - o) & 63) << 2, up);
            if (ln >= o) { b += tb; up += tu; }
        }
        if (ln < 8) { tab[ln] = c; tab[8 + ln] = b - c; tab[16 + ln] = ntm; tab[24 + ln] = up - nu; }
        if (ln == 7) tab[32] = up;
    }
    __syncthreads();
}
struct UpOrder {
    int G, c, pm0, npm;
    __device__ bool next(int i, Unit& u) const {
        const int L = i * G + c; if (L >= npm * 6) return false;
        const int pn = L / npm, pm = pm0 + (L - pn * npm);
        u.arow = pm * 256; u.acolb = (pn >= 3) ? 512 : 0; u.brow = pn * 256; u.orow = pm * 256; u.pn = pn; u.nvalid = 256; u.aux = 0; return true;
    }
};

namespace att {
constexpr int KSLOT = 12288, VSLOT = 8192, FBSLOT = 256, SLOT = KSLOT + VSLOT + FBSLOT;
constexpr int L_WSF = 4 * SLOT;
constexpr int L_TB = L_WSF + 8 * 256;
constexpr int L_OST = L_TB + 512;
constexpr int L_END = L_OST + 8 * 4096;
static_assert(L_END <= RING_BYTES, "attention LDS");
__device__ __forceinline__ int crow(int r, int hi) { return (r & 3) + 8 * (r >> 2) + 4 * hi; }
__device__ __forceinline__ s16x4 vtr(const LAS unsigned char* p) {
    typedef short v4i16_t __attribute__((ext_vector_type(4)));
    return __builtin_bit_cast(s16x4, __builtin_amdgcn_ds_read_tr16_b64_v4i16((LAS v4i16_t*)p));
}
__device__ __forceinline__ float xhalf_max(float m) { auto rr = __builtin_amdgcn_permlane32_swap(__float_as_uint(m), __float_as_uint(m), false, false); return fmaxf(__uint_as_float(rr[0]), __uint_as_float(rr[1])); }
__device__ __forceinline__ float xhalf_sum(float m) { auto rr = __builtin_amdgcn_permlane32_swap(__float_as_uint(m), __float_as_uint(m), false, false); return __uint_as_float(rr[0]) + __uint_as_float(rr[1]); }

struct Tensors { const bf16* Q; const bf16* K; const bf16* V; int qp, kp, vp, qw, kw; bf16* O; int ocol; const float* FB; const float* relb; const float* dlam; const float* subg; float lam_init; };

template <int TYPE>
__device__ __forceinline__ void attn_unit(const Tensors& P, int b, int h, int qb, LAS unsigned char* shm_in, int wid_in) {
    LAS unsigned char* shm = shm_in; int wid = wid_in; asm volatile("" : "+s"(shm), "+s"(wid));
    constexpr int NPASS = (TYPE == 0) ? 2 : 1, DQK = (TYPE == 0) ? 32 : (TYPE == 1 ? 80 : 96), NKC = DQK / 8, ND = DQK / 16, NG = 2 * ND;
    int lane_ = lane_id(); asm volatile("" : "+v"(lane_));
    const int lane = lane_, tid = wid * 64 + lane, r32 = lane & 31, hi = lane >> 5;
    const int nk = (NKC - wid + 7) / 8;
    const long rowbase = (long)b * SEQ; const int q0 = qb * 256;
    const bf16* Kh = P.K + rowbase * P.kp + h * P.kw;
    const bf16* Vh = P.V + rowbase * P.vp + h * 64;
    const unsigned shmb = (unsigned)(uintptr_t)shm;
    LAS float* wsf = (LAS float*)(shm + L_WSF) + wid * 64;
    LAS float* TBs = (LAS float*)(shm + L_TB);
    const int NT = 4 * (qb + 1);
    const int qrow = q0 + wid * 32 + r32;
    const unsigned kvoff = (unsigned)(lane * P.kp * 2), vvoff = (unsigned)(((lane >> 2) * P.vp + (lane & 3) * 8) * 2);
#define ATT_DMA(tk, sk, tv, sv) do { \
        for (int p_ = wid; p_ < NKC; p_ += 8) glds16(Kh + kpass + (long)(64 * (tk)) * P.kp + p_ * 8, kvoff, shmb + (unsigned)(sk) * SLOT + p_ * 1024); \
        glds16(Vh + (long)(64 * (tv) + 16 * (wid & 3)) * P.vp + (wid >> 2) * 32, vvoff, shmb + (unsigned)(sv) * SLOT + KSLOT + wid * 1024); } while (0)
#define ATT_BAR() asm volatile("s_waitcnt lgkmcnt(0)\n\ts_barrier" ::: "memory")
#define ATT_WB0() asm volatile("s_waitcnt vmcnt(0) lgkmcnt(0)\n\ts_barrier" ::: "memory")
#define ATT_WB2() do { if (nk == 0) asm volatile("s_waitcnt vmcnt(2) lgkmcnt(0)\n\ts_barrier" ::: "memory"); else if (nk == 1) asm volatile("s_waitcnt vmcnt(4) lgkmcnt(0)\n\ts_barrier" ::: "memory"); \
        else asm volatile("s_waitcnt vmcnt(6) lgkmcnt(0)\n\ts_barrier" ::: "memory"); } while (0)
#define ATT_SB() __builtin_amdgcn_sched_barrier(0)
#define ATT_PIN(x) asm volatile("" : "+v"(x))
#define ATT_MF(a_, b_, c_) __builtin_amdgcn_mfma_f32_32x32x16_bf16(a_, b_, c_, 0, 0, 0)
    if (TYPE == 0) {
        if (tid < 128) {
            const int n = tid; int bk;
            if (n < 16) bk = n; else { bk = 16; const int th[15] = {19, 21, 24, 27, 31, 35, 40, 46, 52, 59, 67, 77, 87, 99, 113};
#pragma unroll
                for (int k = 0; k < 15; ++k) bk += (n >= th[k]) ? 1 : 0; }
            TBs[n] = (P.relb[bk * 4 + h] - P.relb[31 * 4 + h]) * LOG2E;
        }
    }
    const LAS unsigned char* vp0 = shm + KSLOT + ((lane >> 4) & 1) * 32 + (lane & 3) * 8 + (4 * hi + ((lane & 15) >> 2)) * 64;
    const LAS unsigned char* kp0 = shm + hi * 1024 + r32 * 16;
    f32x16 o[2]; float l_reg = 0.f;
#pragma unroll 1
    for (int pass = 0; pass < NPASS; ++pass) {
    const int kpass = pass * 32;
    ATT_DMA(0, 0, 0, 0); ATT_DMA(1, 1, 1, 1); ATT_DMA(2, 2, 2, 2); ATT_DMA(3, 3, 3, 3);
    bf16x8 qf[ND];
    {
        const bf16* Qp = P.Q + (rowbase + qrow) * P.qp + h * P.qw;
#pragma unroll
        for (int d0 = 0; d0 < ND; ++d0) { if (TYPE == 1 && d0 == ND - 1) qf[d0] = (hi == 0) ? (bf16x8){0x3F80, 0x3F80, 0x3F80, 0, 0, 0, 0, 0} : (bf16x8){0, 0, 0, 0, 0, 0, 0, 0};
                                          else qf[d0] = *(const bf16x8*)(Qp + kpass + d0 * 16 + hi * 8); }
#pragma unroll
        for (int d0 = 0; d0 < ND; ++d0) ATT_PIN(qf[d0]);
    }
    asm volatile("s_waitcnt vmcnt(0)" ::: "memory");
    float mhat = 0.f; l_reg = 0.f; o[0] = zero16_asm(); o[1] = zero16_asm();
    f32x16 negm = zero16_asm();
    f32x16 pA0, pA1, pB0, pB1; bf16x8 kf[NG]; bf16x8 vv[4]; u32x4 pw[4]; bool resc = false;
    ATT_BAR();
#define ATT_KLD(slot, d0) do { const LAS unsigned char* kb_ = kp0 + (slot) * SLOT + (d0) * 2048; kf[2 * (d0)] = *(const LAS bf16x8*)kb_; kf[2 * (d0) + 1] = *(const LAS bf16x8*)(kb_ + 512); } while (0)
#define ATT_VRD(dst, vp_, i) do { const s16x4 lo_ = vtr((vp_) + (((i) >> 2) * 4096 + ((i) & 3) * 1024)), hh_ = vtr((vp_) + (((i) >> 2) * 4096 + ((i) & 3) * 1024 + 512)); \
        dst = (bf16x8){lo_[0], lo_[1], lo_[2], lo_[3], hh_[0], hh_[1], hh_[2], hh_[3]}; } while (0)
#define ATT_NEAR(C0, C1, t) do { \
        int qr_ = qrow; asm volatile("" : "+v"(qr_)); \
        if (TYPE == 0) { _Pragma("unroll") for (int r = 0; r < 16; ++r) { int d0_ = qr_ - (64 * (t) + crow(r, hi)), d1_ = d0_ - 32; \
            d0_ = d0_ < 0 ? 0 : (d0_ > 127 ? 127 : d0_); d1_ = d1_ < 0 ? 0 : (d1_ > 127 ? 127 : d1_); C0[r] += TBs[d0_]; C1[r] += TBs[d1_]; } } \
        if ((t) >= NT - 4) { _Pragma("unroll") for (int r = 0; r < 16; ++r) { const int kv = 64 * (t) + crow(r, hi); if (kv > qr_) C0[r] = -INFINITY; if (kv + 32 > qr_) C1[r] = -INFINITY; } } } while (0)
#define ATT_RMAX(C0, C1, rm) do { float a_ = __builtin_fmaxf(__builtin_fmaxf(C0[0], C0[1]), C1[0]), b_ = __builtin_fmaxf(__builtin_fmaxf(C0[2], C0[3]), C1[1]); a_ = __builtin_fmaxf(__builtin_fmaxf(a_, C1[2]), C1[3]); \
        _Pragma("unroll") for (int r = 4; r < 16; r += 4) { a_ = __builtin_fmaxf(__builtin_fmaxf(a_, C0[r]), C0[r + 1]); b_ = __builtin_fmaxf(__builtin_fmaxf(b_, C0[r + 2]), C0[r + 3]); \
            a_ = __builtin_fmaxf(__builtin_fmaxf(a_, C1[r]), C1[r + 1]); b_ = __builtin_fmaxf(__builtin_fmaxf(b_, C1[r + 2]), C1[r + 3]); } \
        rm = xhalf_max(__builtin_fmaxf(a_, b_)); } while (0)
#pragma unroll
    for (int d0 = 0; d0 < ND; ++d0) ATT_KLD(0, d0);
#pragma unroll
    for (int d0 = 0; d0 < ND; ++d0) { pA0 = ATT_MF(kf[2 * d0], qf[d0], d0 == 0 ? negm : pA0); pA1 = ATT_MF(kf[2 * d0 + 1], qf[d0], d0 == 0 ? negm : pA1); }
    if (NT == 4) ATT_NEAR(pA0, pA1, 0);
    { float rm; ATT_RMAX(pA0, pA1, rm); mhat = rm;
#pragma unroll
      for (int r = 0; r < 16; ++r) negm[r] = -mhat;
#pragma unroll
      for (int r = 0; r < 16; ++r) { pA0[r] = fexp2(pA0[r] - rm); pA1[r] = fexp2(pA1[r] - rm); } }
    ATT_BAR();
    ATT_DMA((4 < NT ? 4 : NT - 1), 0, 2, 2);
#pragma unroll
    for (int d0 = 0; d0 < ND; ++d0) ATT_KLD(1, d0);
    ATT_WB2();
#define ATT_FILL(P0, P1, g) do { const int e_ = 4 * ((g) & 3); \
        if ((g) < 4) { sacc += P0[e_]; sacc += P0[e_ + 1]; sacc += P0[e_ + 2]; sacc += P0[e_ + 3]; pw[(g) >> 1][2 * ((g) & 1)] = cvt_pk_bf16(P0[e_], P0[e_ + 1]); pw[(g) >> 1][2 * ((g) & 1) + 1] = cvt_pk_bf16(P0[e_ + 2], P0[e_ + 3]); } \
        else { sacc += P1[e_]; sacc += P1[e_ + 1]; sacc += P1[e_ + 2]; sacc += P1[e_ + 3]; pw[(g) >> 1][2 * ((g) & 1)] = cvt_pk_bf16(P1[e_], P1[e_ + 1]); pw[(g) >> 1][2 * ((g) & 1) + 1] = cvt_pk_bf16(P1[e_ + 2], P1[e_ + 3]); } \
        ATT_PIN(pw[(g) >> 1]); ATT_PIN(sacc); } while (0)
#define ATT_STEP(C0, C1, P0, P1, t) do { ATT_SB(); \
        float sacc = 0.f; \
        _Pragma("unroll") for (int g = 0; g < NG; ++g) { \
            if ((g & 1) == 0) C0 = ATT_MF(kf[g], qf[g >> 1], g < 2 ? negm : C0); else C1 = ATT_MF(kf[g], qf[g >> 1], g < 2 ? negm : C1); \
            if (NG >= 8) { if (g < 8) ATT_FILL(P0, P1, g); } else { ATT_FILL(P0, P1, 2 * g); ATT_FILL(P0, P1, 2 * g + 1); } \
            ATT_SB(); } \
        const LAS unsigned char* vp_ = vp0 + (((t) - 1) & 3) * SLOT; \
        ATT_VRD(vv[0], vp_, 0); ATT_VRD(vv[1], vp_, 4); ATT_SB(); \
        l_reg += sacc; \
        { const int tk_ = (t) + 4 < NT ? (t) + 4 : NT - 1, tv_ = (t) + 2 < NT ? (t) + 2 : NT - 1; ATT_DMA(tk_, (t) & 3, tv_, ((t) + 2) & 3); } \
        if ((t) >= NT - 6) ATT_NEAR(C0, C1, t); \
        { float rm; ATT_RMAX(C0, C1, rm); resc = false; \
          if (__builtin_expect(__any(rm > 32.f), 0)) { const float dl = __builtin_fmaxf(rm, 0.f); mhat += dl;            \
              _Pragma("unroll") for (int r = 0; r < 16; ++r) negm[r] = -mhat; \
              _Pragma("unroll") for (int r = 0; r < 16; ++r) { C0[r] -= dl; C1[r] -= dl; } \
              const float f = fexp2(-dl); l_reg *= f; if (hi == 0) wsf[r32] = f; resc = true; } } \
        ATT_SB(); \
        _Pragma("unroll") for (int j = 0; j < 8; ++j) { \
            if (j + 2 < 8) { const int i_ = ((j + 2) >> 1) + 4 * ((j + 2) & 1); ATT_VRD(vv[(j + 2) & 3], vp_, i_); } \
            if (j >= 1 && j <= ND) ATT_KLD(((t) + 1) & 3, j - 1); \
            ATT_SB(); \
            o[j & 1] = ATT_MF(__builtin_bit_cast(bf16x8, pw[j >> 1]), vv[j & 3], o[j & 1]); \
            if (j < 4) { C0[4 * j] = fexp2(C0[4 * j]); C0[4 * j + 1] = fexp2(C0[4 * j + 1]); C0[4 * j + 2] = fexp2(C0[4 * j + 2]); C0[4 * j + 3] = fexp2(C0[4 * j + 3]); ATT_PIN(C0); } \
            else { C1[4 * j - 16] = fexp2(C1[4 * j - 16]); C1[4 * j - 15] = fexp2(C1[4 * j - 15]); C1[4 * j - 14] = fexp2(C1[4 * j - 14]); C1[4 * j - 13] = fexp2(C1[4 * j - 13]); ATT_PIN(C1); } \
            ATT_SB(); } \
    } while (0)
#define ATT_RESC() do { if (resc) { _Pragma("unroll") for (int r = 0; r < 16; ++r) { const float f_ = wsf[crow(r, hi)]; o[0][r] *= f_; o[1][r] *= f_; } } } while (0)
    {
        int t = 1;
#pragma unroll 1
        for (; t + 1 < NT; t += 2) {
            ATT_STEP(pB0, pB1, pA0, pA1, t);     ATT_WB2(); ATT_RESC();
            ATT_STEP(pA0, pA1, pB0, pB1, t + 1); ATT_WB2(); ATT_RESC();
        }
        ATT_STEP(pB0, pB1, pA0, pA1, NT - 1); ATT_WB0(); ATT_RESC();
    }
    { float sacc = 0.f;
#pragma unroll
      for (int r = 0; r < 16; ++r) sacc += pB0[r];
#pragma unroll
      for (int r = 0; r < 16; ++r) sacc += pB1[r];
      l_reg += sacc;
#pragma unroll
      for (int k = 0; k < 2; ++k) {
          pw[k] = (u32x4){cvt_pk_bf16(pB0[8 * k + 0], pB0[8 * k + 1]), cvt_pk_bf16(pB0[8 * k + 2], pB0[8 * k + 3]), cvt_pk_bf16(pB0[8 * k + 4], pB0[8 * k + 5]), cvt_pk_bf16(pB0[8 * k + 6], pB0[8 * k + 7])};
          pw[2 + k] = (u32x4){cvt_pk_bf16(pB1[8 * k + 0], pB1[8 * k + 1]), cvt_pk_bf16(pB1[8 * k + 2], pB1[8 * k + 3]), cvt_pk_bf16(pB1[8 * k + 4], pB1[8 * k + 5]), cvt_pk_bf16(pB1[8 * k + 6], pB1[8 * k + 7])}; }
      const LAS unsigned char* vp_ = vp0 + 3 * SLOT;
#pragma unroll
      for (int j = 0; j < 8; ++j) { const int i_ = (j >> 1) + 4 * (j & 1); bf16x8 vf_; ATT_VRD(vf_, vp_, i_); o[j & 1] = ATT_MF(__builtin_bit_cast(bf16x8, pw[j >> 1]), vf_, o[j & 1]); } }
    ATT_BAR();
    if (TYPE == 0 && pass == 0) {
        const float rl0 = frcp(xhalf_sum(l_reg)); if (hi == 0) wsf[r32] = rl0;
        LDS_WAIT();
        LAS bf16* stg0 = (LAS bf16*)(shm + L_OST) + wid * 2048;
#pragma unroll
        for (int r = 0; r < 16; ++r) { const int orow = crow(r, hi); const float f = wsf[orow];
            const unsigned w = cvt_pk_bf16(o[0][r] * f, o[1][r] * f); stg0[orow * 64 + r32] = (bf16)(w & 0xFFFFu); stg0[orow * 64 + 32 + r32] = (bf16)(w >> 16); }
        LDS_WAIT();
    }
    }
    {
    int le_ = lane_id(); asm volatile("" : "+v"(le_));
    const int r32e = le_ & 31, hie = le_ >> 5;
    { const float rl = frcp(xhalf_sum(l_reg)); if (hie == 0) wsf[r32e] = rl; }
    LDS_WAIT();
    LAS bf16* stg = (LAS bf16*)(shm + L_OST) + wid * 2048;
    float gd[2] = {0.f, 0.f}, lam = 0.f;
    if (TYPE == 0) {
        float s1 = 0.f, s2 = 0.f;
        if (le_ < 32) { s1 = P.dlam[le_] * P.dlam[32 + le_]; s2 = P.dlam[64 + le_] * P.dlam[96 + le_]; }
        s1 = wave_sum(s1); s2 = wave_sum(s2);
        unsigned liu_ = __builtin_amdgcn_readfirstlane(__float_as_uint(P.lam_init)); asm volatile("" : "+s"(liu_)); const float lam_init = __uint_as_float(liu_);
        lam = __expf(s1) - __expf(s2) + lam_init;
        gd[0] = P.subg[r32e] * (1.f - lam_init); gd[1] = P.subg[32 + r32e] * (1.f - lam_init);
    }
#pragma unroll
    for (int r = 0; r < 16; ++r) {
        const int orow = crow(r, hie);
        float v0, v1;
        if (TYPE == 0) {
            const float rb = wsf[orow] * lam;
            v0 = bf2f(stg[orow * 64 + r32e]) - o[0][r] * rb; v1 = bf2f(stg[orow * 64 + 32 + r32e]) - o[1][r] * rb;
            float ss = v0 * v0 + v1 * v1;
            ss += xor_lane<1>(ss); ss += xor_lane<2>(ss); ss += xor_lane<4>(ss); ss += xor_lane<8>(ss); ss += xor_lane<16>(ss);
            const float rn = rsqrtf(ss * (1.f / 64.f) + EPS);
            v0 *= rn * gd[0]; v1 *= rn * gd[1];
        } else {
            const float ra = wsf[orow]; v0 = o[0][r] * ra; v1 = o[1][r] * ra;
        }
        stg[orow * 64 + r32e] = (bf16)(cvt_pk_bf16(v0, v0) & 0xFFFFu);
        stg[orow * 64 + 32 + r32e] = (bf16)(cvt_pk_bf16(v1, v1) & 0xFFFFu);
    }
    LDS_WAIT();
    bf16* Ow = P.O + (rowbase + q0 + wid * 32) * DM + P.ocol + h * 64;
#pragma unroll
    for (int i = 0; i < 4; ++i) { const int row = i * 8 + (le_ >> 3), ch = le_ & 7; const u32x4 v = *(const LAS u32x4*)(stg + row * 64 + ch * 8); *(u32x4*)(Ow + (long)row * DM + ch * 8) = v; }
    }
    ATT_BAR();
#undef ATT_DMA
#undef ATT_BAR
#undef ATT_WB0
#undef ATT_WB2
#undef ATT_SB
#undef ATT_PIN
#undef ATT_MF
#undef ATT_KLD
#undef ATT_VRD
#undef ATT_NEAR
#undef ATT_RMAX
#undef ATT_FILL
#undef ATT_STEP
#undef ATT_RESC
}
__device__ __forceinline__ void decode_unit(int u, int& type, int& qb, int& b, int& h) {
    const int order[24] = {0 * 8 + 7, 0 * 8 + 6, 0 * 8 + 5, 0 * 8 + 4, 2 * 8 + 7, 1 * 8 + 7, 2 * 8 + 6, 0 * 8 + 3, 1 * 8 + 6, 2 * 8 + 5, 1 * 8 + 5, 0 * 8 + 2,
                           2 * 8 + 4, 1 * 8 + 4, 0 * 8 + 1, 2 * 8 + 3, 1 * 8 + 3, 2 * 8 + 2, 1 * 8 + 2, 0 * 8 + 0, 2 * 8 + 1, 1 * 8 + 1, 2 * 8 + 0, 1 * 8 + 0};
    int rem = u; type = 0; qb = 0;
#pragma unroll
    for (int k = 0; k < 24; ++k) { const int ty = order[k] >> 3; const int n = (ty == 0) ? 32 : 48; if (rem >= 0 && rem < n) { type = ty; qb = order[k] & 7; const int nh = (ty == 0) ? 4 : 6; b = rem / nh; h = rem - b * nh; } rem -= n; }
}
__device__ __forceinline__ void decode_unit_local(int u, int& type, int& qb, int& h) {
    const int order[24] = {0 * 8 + 7, 0 * 8 + 6, 0 * 8 + 5, 0 * 8 + 4, 2 * 8 + 7, 1 * 8 + 7, 2 * 8 + 6, 0 * 8 + 3, 1 * 8 + 6, 2 * 8 + 5, 1 * 8 + 5, 0 * 8 + 2,
                           2 * 8 + 4, 1 * 8 + 4, 0 * 8 + 1, 2 * 8 + 3, 1 * 8 + 3, 2 * 8 + 2, 1 * 8 + 2, 0 * 8 + 0, 2 * 8 + 1, 1 * 8 + 1, 2 * 8 + 0, 1 * 8 + 0};
    int rem = u; type = 0; qb = 0; h = 0;
#pragma unroll
    for (int k = 0; k < 24; ++k) { const int ty = order[k] >> 3; const int n = (ty == 0) ? 4 : 6; if (rem >= 0 && rem < n) { type = ty; qb = order[k] & 7; h = rem; } rem -= n; }
}
}

struct Args { const float* in[24]; float* out; unsigned char* ws; int ph_lo, ph_hi; };
typedef const __attribute__((address_space(4))) Args* ArgP;
__device__ __forceinline__ ArgP argp() { ArgP p = (ArgP)__builtin_amdgcn_kernarg_segment_ptr(); asm volatile("" : "+s"(p)); return p; }
enum { I_X = 0, I_C, I_WADA, I_BADA, I_ANORM, I_FNORM, I_WIN, I_BFORGET, I_DLAM, I_SUBLN, I_RELB, I_QNORM, I_KVNORM, I_WUQ, I_WUKV, I_WOUT,
       I_FGATE, I_FUP, I_FDOWN, I_ROUTER, I_MGATE, I_MUP, I_MDOWN, I_FINAL };

__device__ __forceinline__ int dstrow(int kind, int n) {
    if (kind == 0) return n;
    if (kind == 1) { if (n < 1920) return n; if (n < 1926) return 2336 + (n - 1920); if (n < 2182) return 1920 + (n - 1926); if (n < 2310) return 2176 + (n - 2182); return 2304 + (n - 2310); }
    if (kind == 2) return 256 * (n >> 7) + (n & 127);
    if (kind == 3) return 256 * (n >> 7) + 128 + (n & 127);
    if (kind == 4) { const int h = n / 96, d = n - h * 96; if (d < 64) return h * 64 + d; const int rd = d - 64, n2 = rd >> 4, i = rd & 15; return 384 + h * 32 + 8 * (i >> 2) + 4 * n2 + (i & 3); }
    { const int h = n >> 7, d = n & 127; return d < 64 ? 768 + h * 64 + d : 1152 + h * 64 + (d - 64); }
}
__device__ __forceinline__ void transpose_item(const float* W, int N, bf16* WT, int ldd, int kind, const float* kscale, LAS float* scr, int item, int lane) {
    const int nblk = (N + 31) >> 5, kb = item / nblk, nb = item - kb * nblk, k0 = 64 * kb, n0 = 32 * nb;
    const int nn = n0 + (lane & 31); const bool inb = nn < N;
    float tv[32];
#pragma unroll
    for (int i = 0; i < 32; ++i) { const int kk = 2 * i + (lane >> 5); tv[i] = inb ? W[(size_t)(k0 + kk) * N + nn] : 0.f; }
#pragma unroll
    for (int i = 0; i < 32; ++i) { const int kk = 2 * i + (lane >> 5); float v = tv[i]; if (kscale) v *= kscale[k0 + kk]; scr[kk * 33 + (lane & 31)] = v; }
    LDS_WAIT(); asm volatile("" ::: "memory");
    const int c = lane & 7;
#pragma unroll
    for (int j = 0; j < 4; ++j) { const int nl = (lane >> 3) + 8 * j; const int n = n0 + nl; const LAS float* s = scr + (8 * c) * 33 + nl;
        if (n < N) { const int dr = dstrow(kind, n);
            u32x4 o; o.x = cvt_pk_bf16(s[0 * 33], s[1 * 33]); o.y = cvt_pk_bf16(s[2 * 33], s[3 * 33]); o.z = cvt_pk_bf16(s[4 * 33], s[5 * 33]); o.w = cvt_pk_bf16(s[6 * 33], s[7 * 33]);
            *(u32x4*)(WT + (size_t)dr * ldd + k0 + 8 * c) = o; } }
    LDS_WAIT(); asm volatile("" ::: "memory");
}
__device__ __forceinline__ void transpose_item8(const float* W, int N, fp8* WT, int ldd, int kind, LAS float* scr, int item, int lane) {
    const int nblk = (N + 31) >> 5, kb = item / nblk, nb = item - kb * nblk, k0 = 128 * kb, n0 = 32 * nb;
    const int nl = lane & 31, h = lane >> 5, nn = n0 + nl; const bool inb = nn < N;
    LAS unsigned* P = (LAS unsigned*)scr;
#pragma unroll
    for (int sub = 0; sub < 2; ++sub) {
        float tv[32];
#pragma unroll
        for (int i = 0; i < 32; ++i) tv[i] = inb ? W[(size_t)(k0 + 64 * sub + 32 * h + i) * N + nn] : 0.f;
#pragma unroll
        for (int d = 0; d < 8; ++d) P[nl * 33 + 16 * sub + 8 * h + d] = pk4_fp8(tv[4 * d] * 64.f, tv[4 * d + 1] * 64.f, tv[4 * d + 2] * 64.f, tv[4 * d + 3] * 64.f);
    }
    LDS_WAIT(); asm volatile("" ::: "memory");
    const int ch = lane & 7;
#pragma unroll
    for (int j = 0; j < 4; ++j) { const int nr = (lane >> 3) + 8 * j; const int n = n0 + nr; const LAS unsigned* p = P + nr * 33 + 4 * ch;
        if (n < N) { const int dr = dstrow(kind, n); u32x4 o; o.x = p[0]; o.y = p[1]; o.z = p[2]; o.w = p[3];
            *(u32x4*)(WT + (size_t)dr * ldd + k0 + 16 * ch) = o; } }
    LDS_WAIT(); asm volatile("" ::: "memory");
}
template <int ES>
__device__ __forceinline__ void transpose_tile(const float* W, int N, unsigned char* WT, int lddB, int kind, LAS unsigned char* lds, int tile, int wid, int lane) {
    constexpr int KT = 128 / ES, KW = KT / 8;
    const int ntn = (N + 511) >> 9, kb = tile / ntn, nb = tile - kb * ntn, k0 = kb * KT, n0 = nb * 512;
    f32x4 v[KW][2];
#pragma unroll
    for (int r = 0; r < KW; ++r)
#pragma unroll
        for (int c = 0; c < 2; ++c) { const int nn = n0 + 256 * c + 4 * lane; v[r][c] = (nn < N) ? *(const f32x4*)(W + (size_t)(k0 + wid * KW + r) * N + nn) : (f32x4){0.f, 0.f, 0.f, 0.f}; }
#pragma unroll
    for (int c = 0; c < 2; ++c)
#pragma unroll
        for (int j = 0; j < 4; ++j) {
            u32x4 o;
            if constexpr (ES == 1) {
                o.x = pk4_fp8(v[0][c][j] * 64.f, v[1][c][j] * 64.f, v[2][c][j] * 64.f, v[3][c][j] * 64.f); o.y = pk4_fp8(v[4][c][j] * 64.f, v[5][c][j] * 64.f, v[6][c][j] * 64.f, v[7][c][j] * 64.f);
                o.z = pk4_fp8(v[8][c][j] * 64.f, v[9][c][j] * 64.f, v[10][c][j] * 64.f, v[11][c][j] * 64.f); o.w = pk4_fp8(v[12][c][j] * 64.f, v[13][c][j] * 64.f, v[14][c][j] * 64.f, v[15][c][j] * 64.f);
            } else {
                o.x = cvt_pk_bf16(v[0][c][j], v[1][c][j]); o.y = cvt_pk_bf16(v[2][c][j], v[3][c][j]); o.z = cvt_pk_bf16(v[4][c][j], v[5][c][j]); o.w = cvt_pk_bf16(v[6][c][j], v[7][c][j]);
            }
            const int row = 256 * c + 4 * lane + j;
            *(LAS u32x4*)(lds + row * 128 + ((wid ^ ((row >> 2) & 7)) << 4)) = o;
        }
    __syncthreads();
#pragma unroll
    for (int i = 0; i < 8; ++i) {
        const int row = 64 * wid + 8 * i + (lane >> 3), ch = lane & 7, n = n0 + row;
        if (n < N) { const u32x4 o = *(const LAS u32x4*)(lds + row * 128 + ((ch ^ ((row >> 2) & 7)) << 4)); *(u32x4*)(WT + (size_t)dstrow(kind, n) * lddB + k0 * ES + 16 * ch) = o; }
    }
    __syncthreads();
}
__device__ __forceinline__ void prologue(ArgP a, LAS unsigned char* lds, int wid, int Gx, int Bx) {
    const int lane = lane_id(), tid = wid * 64 + lane;
    const int G = Gx, bx = Bx;
    unsigned char* ws = a->ws;
    {
        const int gw = bx * NWAVES + wid;
        if (gw % 5 == 0 && gw / 5 < 384) {
            const int it = gw / 5, l = it / 192, rem = it - l * 192, kc = rem / 24, cb = rem - kc * 24;
            LAS float* ctab = (LAS float*)(lds + wid * 16384);
#pragma unroll
            for (int q = 0; q < 16; ++q) { const int idx = q * 64 + lane, b = idx >> 7, jj = idx & 127; const float v = a->in[I_C][b * 1024 + kc * 128 + jj]; ctab[idx] = v * frcp(1.f + __expf(-v)); }
            LDS_WAIT(); asm volatile("" ::: "memory");
            f32x4 acc[8];
#pragma unroll
            for (int b = 0; b < 8; ++b) acc[b] = (f32x4){0.f, 0.f, 0.f, 0.f};
            const float* wp = a->in[I_WADA] + ((size_t)l * 1024 + kc * 128) * 6144 + cb * 256 + 4 * lane;
#pragma unroll 1
            for (int k0 = 0; k0 < 128; k0 += 8) {
                f32x4 w[8];
#pragma unroll
                for (int k = 0; k < 8; ++k) w[k] = *(const f32x4*)(wp + (size_t)(k0 + k) * 6144);
#pragma unroll
                for (int k = 0; k < 8; ++k)
#pragma unroll
                    for (int b = 0; b < 8; ++b) acc[b] += w[k] * ctab[b * 128 + k0 + k];
            }
            float* mp = (float*)(ws + WS_MODP) + ((size_t)(kc * 2 + l) * 8) * 6144 + cb * 256 + 4 * lane;
#pragma unroll
            for (int b = 0; b < 8; ++b) *(f32x4*)(mp + (size_t)b * 6144) = acc[b];
            LDS_WAIT(); asm volatile("" ::: "memory");
        }
    }
    {
        const double fr[16] = {1.0, 0.5623413251903491, 0.31622776601683794, 0.1778279410038923, 0.1, 0.05623413251903491, 0.03162277660168379, 0.01778279410038923,
                               0.01, 0.005623413251903491, 0.0031622776601683794, 0.0017782794100389228, 0.001, 0.0005623413251903491, 0.00031622776601683794, 0.00017782794100389227};
        const int gt = bx * NTHREADS + tid;
        if (gt < SEQ * 16) {
            const int pos = gt >> 4, i = gt & 15; double f = fr[0];
#pragma unroll
            for (int k = 1; k < 16; ++k) f = (i == k) ? fr[k] : f;
            const double rev = (double)pos * f * 0.15915494309189535; const double frac = rev - __builtin_floor(rev + 0.5);
            ((float*)(ws + WS_COS))[gt] = __builtin_amdgcn_cosf((float)frac); ((float*)(ws + WS_SIN))[gt] = __builtin_amdgcn_sinf((float)frac);
        }
    }
    {
        const int gt = bx * NTHREADS + tid, GT = G * NTHREADS; const u32x4 z = (u32x4){0u, 0u, 0u, 0u};
        for (int l = 0; l < 2; ++l) {
            bf16* win = (bf16*)(ws + WS_WIN) + (size_t)l * NIN * 1024;
            for (int i = gt; i < (NIN - INW) * 128; i += GT) *(u32x4*)(win + (size_t)INW * 1024 + (size_t)i * 8) = z;
            bf16* wup = (bf16*)(ws + WS_WUP) + (size_t)l * 1536 * 256;
            for (int i = gt; i < 192 * 32; i += GT) *(u32x4*)(wup + (size_t)576 * 256 + (size_t)i * 8) = z;
            for (int i = gt; i < 768 * 16; i += GT) { const int r = i >> 4, c = i & 15; *(u32x4*)(wup + (size_t)(768 + r) * 256 + 128 + c * 8) = z; }
        }
    }
    {
        LAS float* scr = (LAS float*)(lds + wid * 16384);
        const int gw = bx * NWAVES + wid, NGW = G * NWAVES;
        constexpr int I_IN = 16 * 74, I_UQ = 4 * 18, I_UKV = 2 * 24;
        constexpr int NITEMS = 2 * (I_IN + I_UQ + I_UKV);
        for (int it = gw; it < NITEMS; it += NGW) {
            int r = it;
            if (r < 2 * I_IN) { const int l = r / I_IN; r -= l * I_IN; transpose_item(a->in[I_WIN] + (size_t)l * 1024 * INW, INW, (bf16*)(ws + WS_WIN) + (size_t)l * NIN * 1024, 1024, 1, nullptr, scr, r, lane); continue; } r -= 2 * I_IN;
            if (r < 2 * I_UQ) { const int l = r / I_UQ; r -= l * I_UQ; transpose_item(a->in[I_WUQ] + (size_t)l * 256 * 576, 576, (bf16*)(ws + WS_WUP) + (size_t)l * 1536 * 256, 256, 4, a->in[I_QNORM] + l * 256, scr, r, lane); continue; } r -= 2 * I_UQ;
            { const int l = r / I_UKV; r -= l * I_UKV; transpose_item(a->in[I_WUKV] + (size_t)l * 128 * 768, 768, (bf16*)(ws + WS_WUP) + (size_t)l * 1536 * 256, 256, 5, a->in[I_KVNORM] + l * 128, scr, r, lane); }
        }
    }
    __syncthreads();
    {
        constexpr int T_OUT = 16 * 2, T_FG = 16 * 6, T_FD = 44 * 2;
        constexpr int NTILES = 2 * T_OUT + 2 * T_FG + T_FD;
        for (int it = bx; it < NTILES; it += G) {
            int r = it;
            if (r < 2 * T_OUT) { const int l = r / T_OUT; r -= l * T_OUT; transpose_tile<2>(a->in[I_WOUT] + (size_t)l * 1024 * 1024, 1024, ws + WS_WOUT + (size_t)l * 1024 * 1024 * 2, 2048, 0, lds, r, wid, lane); continue; } r -= 2 * T_OUT;
            if (r < T_FG) { transpose_tile<2>(a->in[I_FGATE], FFD, ws + WS_WGU, 2048, 2, lds, r, wid, lane); continue; } r -= T_FG;
            if (r < T_FG) { transpose_tile<2>(a->in[I_FUP], FFD, ws + WS_WGU, 2048, 3, lds, r, wid, lane); continue; } r -= T_FG;
            transpose_tile<2>(a->in[I_FDOWN], 1024, ws + WS_WDN, FFD * 2, 0, lds, r, wid, lane);
        }
    }
}
constexpr int CONV_TILES = 8 * (2 * 56 + 56);
__device__ __forceinline__ void moe_convert(ArgP a, LAS unsigned char* lds_in, int wid_in, int quota) {
    LAS unsigned char* lds = lds_in; int wid = wid_in; asm volatile("" : "+s"(lds), "+s"(wid));
    const int lane = lane_id();
    unsigned char* ws = a->ws;
    volatile LAS unsigned* mq = (volatile LAS unsigned*)(lds + MISC_OFF);
    for (int q = 0; q < quota; ++q) {
        if (wid == 0 && lane == 0) mq[6] = __hip_atomic_fetch_add((unsigned*)(ws + WS_CTL) + CW_CONVQ, 1u, RLX_AGENT);
        __syncthreads();
        const int idx = (int)mq[6];
        if (idx >= CONV_TILES) break;
        const int e = idx / 168; int r = idx - e * 168;
        if (r < 56) transpose_tile<1>(a->in[I_MGATE] + (size_t)e * 1024 * FFE, FFE, ws + WS_MGU + (size_t)e * 2 * FFE * 1024, 1024, 2, lds, r, wid, lane);
        else if (r < 112) transpose_tile<1>(a->in[I_MUP] + (size_t)e * 1024 * FFE, FFE, ws + WS_MGU + (size_t)e * 2 * FFE * 1024, 1024, 3, lds, r - 56, wid, lane);
        else transpose_tile<1>(a->in[I_MDOWN] + (size_t)e * FFE * 1024, 1024, ws + WS_MDN + (size_t)e * 1024 * FFE, FFE, 0, lds, r - 112, wid, lane);
    }
    __syncthreads();
}

template <int MODE>
__device__ __forceinline__ void norm_phase(ArgP a, int l, const float* xin, LAS unsigned char* lds_in, int wid_in, int Gx, int Bx, int pm0, int npm, int gsplit = 0) {
    LAS unsigned char* lds = lds_in; int wid = wid_in; asm volatile("" : "+s"(lds), "+s"(wid));
    int lane_ = lane_id(); asm volatile("" : "+v"(lane_));
    const int lane = lane_, tid = wid * 64 + lane;
    unsigned char* ws = a->ws; const int bx = Bx;
    LAS float* TA = (LAS float*)lds; LAS float* TBv = (LAS float*)(lds + 4096);
    LAS float* RW = (LAS float*)(lds + 8192);
    volatile LAS int* RI = (volatile LAS int*)(lds + 8192 + 32768);
    volatile LAS float* RWT = (volatile LAS float*)(lds + 8192 + 32768 + 1024);
    volatile LAS int* LC = (volatile LAS int*)(lds + 8192 + 32768 + 2048);
    const float* mod = (const float*)(ws + WS_MOD);
    const bool from_part = (MODE == 0) && (l == 0);
    const float* modp = (const float*)(ws + WS_MODP);
#define MODV(l_, b_, j_) (from_part ? ({ float s_ = a->in[I_BADA][(l_) * 6144 + (j_)]; _Pragma("unroll") for (int kc_ = 0; kc_ < 8; ++kc_) s_ += modp[((size_t)(kc_ * 2 + (l_)) * 8 + (b_)) * 6144 + (j_)]; s_; }) : mod[((size_t)(l_) * 8 + (b_)) * 6144 + (j_)])
    if (from_part) {
        const int nb_ = npm >> 3, per_ = nb_ * 6144;
        for (int e = bx * NTHREADS + tid; e < 2 * per_; e += Gx * NTHREADS) { const int l2 = e / per_, r2 = e - l2 * per_, b2 = (pm0 >> 3) + r2 / 6144, j2 = r2 % 6144; ((float*)(ws + WS_MOD))[((size_t)l2 * 8 + b2) * 6144 + j2] = MODV(l2, b2, j2); }
    }
    for (int rb = 4 * pm0 + bx; rb < 4 * (pm0 + npm); rb += Gx) {
        const int b = rb >> 5;
        for (int j = tid; j < 1024; j += NTHREADS) {
            float ga, be;
            if (MODE == 0) { ga = a->in[I_ANORM][l * 1024 + j] * (1.f + MODV(l, b, 1024 + j)); be = MODV(l, b, j); }
            else if (MODE == 3) { ga = a->in[I_FINAL][j]; be = 0.f; }
            else { ga = a->in[I_FNORM][l * 1024 + j] * (1.f + mod[((size_t)l * 8 + b) * 6144 + 4096 + j]); be = mod[((size_t)l * 8 + b) * 6144 + 3072 + j]; }
            TA[j] = ga; TBv[j] = be;
        }
        if (MODE == 2) { for (int j = tid; j < 8192; j += NTHREADS) RW[j] = a->in[I_ROUTER][j]; if (tid < 8) LC[tid] = 0; }
        __syncthreads();
#define NORM_LOADROW(dst, row_) do { _Pragma("unroll") for (int j = 0; j < 4; ++j) { \
                if (xin) dst[j] = *(const f32x4*)(xin + (size_t)(row_) * DM + 4 * lane + 256 * j); \
                else { const u32x2 y = *(const u32x2*)((const bf16*)(ws + WS_XR) + (size_t)(row_) * DM + 4 * lane + 256 * j); \
                    dst[j] = (f32x4){__uint_as_float(y.x << 16), __uint_as_float(y.x & 0xFFFF0000u), __uint_as_float(y.y << 16), __uint_as_float(y.y & 0xFFFF0000u)}; } \
                if (MODE == 3) { const u32x2 y = *(const u32x2*)((const bf16*)(ws + WS_Y1) + (size_t)(row_) * DM + 4 * lane + 256 * j); \
                    dst[j][0] += __uint_as_float(y.x << 16); dst[j][1] += __uint_as_float(y.x & 0xFFFF0000u); dst[j][2] += __uint_as_float(y.y << 16); dst[j][3] += __uint_as_float(y.y & 0xFFFF0000u); } } } while (0)
        f32x4 vn[4];
        if (MODE == 2) NORM_LOADROW(vn, rb * 64 + wid * 8);
        f32x4 rwr[(MODE == 2) ? 16 : 1][2];
        if (MODE == 2) {
#pragma unroll
            for (int j = 0; j < 4; ++j)
#pragma unroll
                for (int q = 0; q < 4; ++q) { const LAS f32x4* rw = (const LAS f32x4*)(RW + (size_t)(4 * lane + 256 * j + q) * 8); rwr[j * 4 + q][0] = rw[0]; rwr[j * 4 + q][1] = rw[1]; }
        }
        for (int rr = 0; rr < 8; ++rr) {
            const int rloc = wid * 8 + rr; const int row = rb * 64 + rloc;
            f32x4 v[4]; float s = 0.f;
            if (MODE == 2) {
#pragma unroll
                for (int j = 0; j < 4; ++j) v[j] = vn[j];
                if (rr + 1 < 8) NORM_LOADROW(vn, row + 1);
            } else NORM_LOADROW(v, row);
#pragma unroll
            for (int j = 0; j < 4; ++j) s += (v[j][0] * v[j][0] + v[j][1] * v[j][1]) + (v[j][2] * v[j][2] + v[j][3] * v[j][3]);
            const float rstd = rsqrtf(wave_sum(s) * (1.f / DM) + EPS);
#pragma unroll
            for (int j = 0; j < 4; ++j) { const f32x4 ga = *(const LAS f32x4*)(TA + 4 * lane + 256 * j), be = *(const LAS f32x4*)(TBv + 4 * lane + 256 * j); v[j] = v[j] * rstd * ga + be; }
            if (MODE == 3) {
#pragma unroll
                for (int j = 0; j < 4; ++j) *(f32x4*)(a->out + (size_t)row * DM + 4 * lane + 256 * j) = v[j];
            } else if (MODE == 2) {
                LAS unsigned* rb = (LAS unsigned*)(lds + 49152) + rloc * 256;
#pragma unroll
                for (int j = 0; j < 4; ++j) rb[lane + 64 * j] = pk4_fp8(v[j][0], v[j][1], v[j][2], v[j][3]);
            } else {
                bf16* hrow = (bf16*)(ws + WS_H) + (size_t)row * DM;
#pragma unroll
                for (int j = 0; j < 4; ++j) { u32x2 w; w.x = cvt_pk_bf16(v[j][0], v[j][1]); w.y = cvt_pk_bf16(v[j][2], v[j][3]); *(u32x2*)(hrow + 4 * lane + 256 * j) = w; }
            }
            if (MODE == 0) {
                if (lane < 16) { u32x4 z = (u32x4){0u, 0u, 0u, 0u}; asm volatile("" : "+v"(z)); *(u32x4*)((bf16*)(ws + WS_CQKV) + (size_t)row * 512 + 384 + lane * 8) = z; }
            }
            if (MODE == 2) {
                float lg[8];
#pragma unroll
                for (int e = 0; e < 8; ++e) lg[e] = 0.f;
#pragma unroll
                for (int j = 0; j < 4; ++j)
#pragma unroll
                    for (int q = 0; q < 4; ++q) { const f32x4 w0 = rwr[(MODE == 2) ? j * 4 + q : 0][0], w1 = rwr[(MODE == 2) ? j * 4 + q : 0][1]; const float hv = v[j][q];
                        lg[0] += hv * w0[0]; lg[1] += hv * w0[1]; lg[2] += hv * w0[2]; lg[3] += hv * w0[3]; lg[4] += hv * w1[0]; lg[5] += hv * w1[1]; lg[6] += hv * w1[2]; lg[7] += hv * w1[3]; }
#pragma unroll
                for (int e = 0; e < 8; ++e) lg[e] = wave_sum(lg[e]);
                int e0 = 0; float v0 = lg[0];
#pragma unroll
                for (int e = 1; e < 8; ++e) if (lg[e] > v0) { v0 = lg[e]; e0 = e; }
                int e1 = -1; float v1 = -INFINITY;
#pragma unroll
                for (int e = 0; e < 8; ++e) if (e != e0 && lg[e] > v1) { v1 = lg[e]; e1 = e; }
                const float w1 = frcp(1.f + __expf(v0 - v1)), w0 = 1.f - w1;
                if (lane == 0) { RI[rloc * 4 + 0] = e0; RI[rloc * 4 + 1] = e1; RWT[rloc * 2 + 0] = w0; RWT[rloc * 2 + 1] = w1; }
            }
        }
        if (MODE == 2) {
            __syncthreads();
            if (tid < 64) { const int e0 = RI[tid * 4 + 0], e1 = RI[tid * 4 + 1];
                RI[tid * 4 + 2] = __hip_atomic_fetch_add((LAS int*)&LC[e0], 1, __ATOMIC_RELAXED, __HIP_MEMORY_SCOPE_WORKGROUP);
                RI[tid * 4 + 3] = __hip_atomic_fetch_add((LAS int*)&LC[e1], 1, __ATOMIC_RELAXED, __HIP_MEMORY_SCOPE_WORKGROUP); }
            __syncthreads();
            if (tid < 8) LC[8 + tid] = (int)__hip_atomic_fetch_add((unsigned*)(ws + WS_CTL) + CW_CNT + 64 * tid, (unsigned)LC[tid], RLX_AGENT);
            __syncthreads();
            if (tid < 64) { const int tok = rb * 64 + tid; const int e0 = RI[tid * 4 + 0], e1 = RI[tid * 4 + 1];
                int* perm = (int*)(ws + WS_PERM);
                perm[e0 * T + LC[8 + e0] + RI[tid * 4 + 2]] = tok;
                perm[e1 * T + LC[8 + e1] + RI[tid * 4 + 3]] = tok | (1 << 16);
                ((float*)(ws + WS_TW))[tok * 2 + 0] = RWT[tid * 2 + 0]; ((float*)(ws + WS_TW))[tok * 2 + 1] = RWT[tid * 2 + 1]; }
            if (gsplit) { xcd_barrier_wait((unsigned*)(ws + WS_CTL) + CW_BAR, (volatile LAS unsigned*)(lds + MISC_OFF), wid); gsplit = 0; }
            for (int q = tid; q < 64 * 2 * 64; q += NTHREADS) {
                const int ch = q & 63, sl = (q >> 6) & 1, r = q >> 7;
                const int e = RI[r * 4 + sl], pos = LC[8 + e] + RI[r * 4 + 2 + sl];
                const u32x4 vv = *(const LAS u32x4*)(lds + 49152 + r * 1024 + ch * 16);
                *(u32x4*)((fp8*)(ws + WS_HS8) + ((size_t)e * T + pos) * DM + ch * 16) = vv;
            }
        }
        __syncthreads();
    }
    if (gsplit) xcd_barrier_wait((unsigned*)(ws + WS_CTL) + CW_BAR, (volatile LAS unsigned*)(lds + MISC_OFF), wid);
}

__device__ __forceinline__ void norm1_l0_split(ArgP a, LAS unsigned char* lds_in, int wid_in, int Gx, int Bx, int pm0, int npm) {
    LAS unsigned char* lds = lds_in; int wid = wid_in; asm volatile("" : "+s"(lds), "+s"(wid));
    int lane_ = lane_id(); asm volatile("" : "+v"(lane_));
    const int lane = lane_, tid = wid * 64 + lane;
    unsigned char* ws = a->ws; const int bx = Bx;
    LAS float* TA = (LAS float*)lds; LAS float* TBv = (LAS float*)(lds + 4096);
    const int rb = 4 * pm0 + bx, b = rb >> 5, row0 = rb * 64 + wid * 8;
    const float* xin = a->in[I_X];
    f32x4 v[8][4]; float rstd[8];
#pragma unroll
    for (int rr = 0; rr < 8; ++rr)
#pragma unroll
        for (int j = 0; j < 4; ++j) v[rr][j] = *(const f32x4*)(xin + (size_t)(row0 + rr) * DM + 4 * lane + 256 * j);
#pragma unroll
    for (int rr = 0; rr < 8; ++rr) { float s = 0.f;
#pragma unroll
        for (int j = 0; j < 4; ++j) s += (v[rr][j][0] * v[rr][j][0] + v[rr][j][1] * v[rr][j][1]) + (v[rr][j][2] * v[rr][j][2] + v[rr][j][3] * v[rr][j][3]);
        rstd[rr] = rsqrtf(wave_sum(s) * (1.f / DM) + EPS); }
    xcd_barrier_wait((unsigned*)(ws + WS_CTL) + CW_BAR, (volatile LAS unsigned*)(lds + MISC_OFF), wid);
    const float* modp = (const float*)(ws + WS_MODP);
#define MODV0(l_, b_, j_) ({ float s_ = a->in[I_BADA][(l_) * 6144 + (j_)]; _Pragma("unroll") for (int kc_ = 0; kc_ < 8; ++kc_) s_ += modp[((size_t)(kc_ * 2 + (l_)) * 8 + (b_)) * 6144 + (j_)]; s_; })
    { const int nb_ = npm >> 3, per_ = nb_ * 6144;
      for (int e = bx * NTHREADS + tid; e < 2 * per_; e += Gx * NTHREADS) { const int l2 = e / per_, r2 = e - l2 * per_, b2 = (pm0 >> 3) + r2 / 6144, j2 = r2 % 6144; ((float*)(ws + WS_MOD))[((size_t)l2 * 8 + b2) * 6144 + j2] = MODV0(l2, b2, j2); } }
    for (int j = tid; j < 1024; j += NTHREADS) { TA[j] = a->in[I_ANORM][j] * (1.f + MODV0(0, b, 1024 + j)); TBv[j] = MODV0(0, b, j); }
#undef MODV0
    __syncthreads();
#pragma unroll
    for (int rr = 0; rr < 8; ++rr) {
        const int row = row0 + rr;
        bf16* hrow = (bf16*)(ws + WS_H) + (size_t)row * DM;
#pragma unroll
        for (int j = 0; j < 4; ++j) { const f32x4 ga = *(const LAS f32x4*)(TA + 4 * lane + 256 * j), be = *(const LAS f32x4*)(TBv + 4 * lane + 256 * j); const f32x4 o = v[rr][j] * rstd[rr] * ga + be;
            u32x2 w; w.x = cvt_pk_bf16(o[0], o[1]); w.y = cvt_pk_bf16(o[2], o[3]); *(u32x2*)(hrow + 4 * lane + 256 * j) = w; }
        if (lane < 16) { u32x4 z = (u32x4){0u, 0u, 0u, 0u}; asm volatile("" : "+v"(z)); *(u32x4*)((bf16*)(ws + WS_CQKV) + (size_t)row * 512 + 384 + lane * 8) = z; }
    }
    __syncthreads();
}

__device__ __forceinline__ void up_misc(ArgP a, int l, LAS unsigned char* lds_in, int wid_in, int Gx, int Bx, int pm0, int npm) {
    LAS unsigned char* lds = lds_in; int wid = wid_in; asm volatile("" : "+s"(wid), "+s"(lds));
    int lane_ = lane_id(); asm volatile("" : "+v"(lane_));
    const int lane = lane_, tid = wid * 64 + lane;
    unsigned char* ws = a->ws; const float* misc = (const float*)(ws + WS_MISC);
    if (Bx < 6 * (npm >> 3)) {
        const int b = (pm0 >> 3) + Bx / 6, h = Bx % 6; const float bf = a->in[I_BFORGET][l * 6 + h];
        float c[4]; float run = 0.f;
#pragma unroll
        for (int i = 0; i < 4; ++i) { const float z = misc[(size_t)(b * SEQ + 4 * tid + i) * 64 + 32 + h] + bf;
            const float ls = fminf(z, 0.f) - 0.6931471805599453f * __builtin_amdgcn_logf(1.f + fexp2(-fabsf(z) * LOG2E)); run += ls; c[i] = run; }
        float inc = run;
#pragma unroll
        for (int o = 1; o < 64; o <<= 1) { const int ln = lane_id(); const float t = __uint_as_float((unsigned)__builtin_amdgcn_ds_bpermute(((ln - o) & 63) << 2, (int)__float_as_uint(inc))); if (ln >= o) inc += t; }
        volatile LAS float* wt = (volatile LAS float*)(lds + MISC_OFF + 4096);
        if (lane == 63) wt[wid] = inc;
        __syncthreads();
        float off = inc - run;
#pragma unroll
        for (int w = 0; w < 8; ++w) off += (w < wid) ? wt[w] : 0.f;
        bf16* fk = (bf16*)(ws + WS_FK2) + ((size_t)(b * SEQ + 4 * tid)) * 480 + h * 80 + 64;
#pragma unroll
        for (int i = 0; i < 4; ++i) {
            const float nf = -(off + c[i]) * LOG2E;
            const unsigned h1 = cvt_pk_bf16(nf, 0.f) & 0xFFFFu; const float r1 = nf - __uint_as_float(h1 << 16);
            const unsigned h2 = cvt_pk_bf16(r1, 0.f) & 0xFFFFu; const float r2 = r1 - __uint_as_float(h2 << 16);
            const unsigned h3 = cvt_pk_bf16(r2, 0.f) & 0xFFFFu;
            u32x4 w0 = zero4u_asm(); w0.x = h1 | (h2 << 16); w0.y = h3;
            *(u32x4*)(fk + (size_t)i * 480) = w0; *(u32x4*)(fk + (size_t)i * 480 + 8) = zero4u_asm();
        }
        __syncthreads();
    }
    const float* cosT = (const float*)(ws + WS_COS); const float* sinT = (const float*)(ws + WS_SIN);
    bf16* mk = (bf16*)(ws + WS_MK);
    for (int idx = pm0 * 1024 + Bx * NTHREADS + tid; idx < (pm0 + npm) * 1024; idx += Gx * NTHREADS) {
        const int t = idx >> 2, q = idx & 3, i0 = (q & 1) * 8, pos = t & (SEQ - 1);
        const float* mr = misc + (size_t)t * 64 + i0;
        const f32x4 xa0 = *(const f32x4*)mr, xa1 = *(const f32x4*)(mr + 4), xb0 = *(const f32x4*)(mr + 16), xb1 = *(const f32x4*)(mr + 20);
        const f32x4 c0 = *(const f32x4*)(cosT + pos * 16 + i0), c1 = *(const f32x4*)(cosT + pos * 16 + i0 + 4), s0 = *(const f32x4*)(sinT + pos * 16 + i0), s1 = *(const f32x4*)(sinT + pos * 16 + i0 + 4);
        const f32x4 o0 = (q < 2) ? (xa0 * c0 - xb0 * s0) : (xa0 * s0 + xb0 * c0), o1 = (q < 2) ? (xa1 * c1 - xb1 * s1) : (xa1 * s1 + xb1 * c1);
        u32x4 w; w.x = cvt_pk_bf16(o0[0], o0[1]); w.y = cvt_pk_bf16(o0[2], o0[3]); w.z = cvt_pk_bf16(o1[0], o1[1]); w.w = cvt_pk_bf16(o1[2], o1[3]);
#pragma unroll
        for (int h = 0; h < 6; ++h) *(u32x4*)(mk + (size_t)t * 576 + h * 96 + 64 + q * 8) = w;
    }
}

#ifndef CONV_QUOTA
#define CONV_QUOTA 3
#endif
#define PHASE_PRE() ArgP a = argp(); int Gl = Gx, Bl = Bx; asm volatile("" : "+s"(Gl), "+s"(Bl)); unsigned char* ws = a->ws; (void)ws
#define SLICE_ARGS int Gx, int Bx, int pm0_in, int npm_in, int loc_in
#define SLICE_PRE() PHASE_PRE(); int pm0 = pm0_in, npm = npm_in, loc = loc_in; asm volatile("" : "+s"(pm0), "+s"(npm), "+s"(loc))
__device__ __forceinline__ void ph_norm1(int l, LAS unsigned char* lds, int wid, SLICE_ARGS) { SLICE_PRE(); (void)loc; norm_phase<0>(a, l, (l == 0) ? a->in[I_X] : nullptr, lds, wid, Gl, Bl, pm0, npm); }
__device__ __forceinline__ void ph_inproj(int l, LAS unsigned char* lds, int wid, SLICE_ARGS) {
    SLICE_PRE();
    pg8::Gemm g{ws + WS_H, (const bf16*)(ws + WS_WIN) + (size_t)l * NIN * 1024, 16, 2048, 2048, nullptr};
    pg8::StaticOrder S; S.init(npm, pm0, NIN, Gl, Bl, loc);
    EpiSplit<0> E{ws, nullptr};
    pg8::gemm_phase<EpiSplit<0>, pg8::StaticOrder, false>(lds, g, S, E, wid);
    if (2 * Bl >= Gl) moe_convert(a, lds, wid, CONV_QUOTA);
}
__device__ __forceinline__ void ph_up(int l, LAS unsigned char* lds, int wid, SLICE_ARGS) {
    SLICE_PRE(); (void)loc;
    up_misc(a, l, lds, wid, Gl, Bl, pm0, npm);
    pg8::Gemm g{ws + WS_CQKV, (const bf16*)(ws + WS_WUP) + (size_t)l * 1536 * 256, 4, 1024, 512, nullptr};
    UpOrder S{Gl, Bl, pm0, npm};
    LAS float* rsl = (LAS float*)(lds + MISC_OFF + 8192);
    { const int tid_ = wid * 64 + lane_id();
      if (tid_ < 256 && Bl < npm * 6) { const int pn_ = Bl / npm, pm_ = pm0 + (Bl - pn_ * npm); const float* rp = (const float*)(ws + WS_SSP) + (size_t)(pm_ * 256 + tid_) * 12;
          const f32x4 p0 = *(const f32x4*)rp, p1 = *(const f32x4*)(rp + 4), p2 = *(const f32x4*)(rp + 8);
          const float qs = ((p0[0] + p0[1]) + (p0[2] + p0[3])) + ((p1[0] + p1[1]) + (p1[2] + p1[3])), ks = (p2[0] + p2[1]) + (p2[2] + p2[3]);
          rsl[tid_ * 2] = rsqrtf(qs * (1.f / 256.f) + EPS); rsl[tid_ * 2 + 1] = rsqrtf(ks * (1.f / 128.f) + EPS); }
      __syncthreads(); }
    EpiSplit<1> E{ws, rsl};
    pg8::gemm_phase<EpiSplit<1>, UpOrder, false>(lds, g, S, E, wid);
}
#ifndef ATT_MASK
#define ATT_MASK 7
#endif
__device__ __forceinline__ void ph_attn(int l, int rep, LAS unsigned char* lds, int wid, int loc_in, int xq_in, int split_in) {
    int loc = loc_in, xq = xq_in, waited = split_in ? 0 : 1; asm volatile("" : "+s"(loc), "+s"(xq), "+s"(waited));
    for (;;) {
        ArgP a = argp(); unsigned char* ws = a->ws;
        LAS unsigned char* lp = lds; asm volatile("" : "+s"(lp));
        volatile LAS unsigned* mq = (volatile LAS unsigned*)(lp + MISC_OFF);
        if (wid == 0 && lane_id() == 0) mq[4] = __hip_atomic_fetch_add((unsigned*)(ws + WS_CTL) + CW_ATTQ + 64 * (l + 2 * rep) + (loc ? 4 + 4 * xq : 0), 1u, RLX_AGENT);
        __syncthreads();
        const int u = (int)mq[4];
        if (u >= (loc ? 128 : 1024)) break;
        int type, qb, b, h;
        if (loc) { att::decode_unit_local(u, type, qb, h); b = xq; } else att::decode_unit(u, type, qb, b, h);
        if (!waited && type != 0) { xcd_local_wait((unsigned*)(ws + WS_CTL) + CW_BAR, mq, wid); waited = 1; }
#if defined(ATT_REP_TYPE)
        if (rep && !(type == ATT_REP_TYPE && qb >= ATT_REP_QBMIN && qb <= ATT_REP_QBMAX)) continue;
#endif
        if ((ATT_MASK & 1) && type == 0) {
            att::Tensors TD{(const bf16*)(ws + WS_DQ), (const bf16*)(ws + WS_DK), (const bf16*)(ws + WS_DV), 256, 256, 256, 64, 64, (bf16*)(ws + WS_MERGED), 0,
                            nullptr, a->in[I_RELB], a->in[I_DLAM] + l * 128, a->in[I_SUBLN] + l * 64, (l == 0) ? 0.2f : 0.35550906759096934f};
            att::attn_unit<0>(TD, b, h, qb, lds, wid);
        } else if ((ATT_MASK & 2) && type == 1) {
            att::Tensors TF{(const bf16*)(ws + WS_FQ), (const bf16*)(ws + WS_FK2), (const bf16*)(ws + WS_FV), 384, 480, 384, 64, 80, (bf16*)(ws + WS_MERGED), 256,
                            (const float*)(ws + WS_FB), nullptr, nullptr, nullptr, 0.f};
            att::attn_unit<1>(TF, b, h, qb, lds, wid);
        } else if ((ATT_MASK & 4) && type == 2) {
            att::Tensors TM{(const bf16*)(ws + WS_MQ), (const bf16*)(ws + WS_MK), (const bf16*)(ws + WS_MV), 576, 576, 384, 96, 96, (bf16*)(ws + WS_MERGED), 640,
                            nullptr, nullptr, nullptr, nullptr, 0.f};
            att::attn_unit<2>(TM, b, h, qb, lds, wid);
        }
    }
    if (!waited) { ArgP a = argp(); LAS unsigned char* lp = lds; asm volatile("" : "+s"(lp)); xcd_local_wait((unsigned*)(a->ws + WS_CTL) + CW_BAR, (volatile LAS unsigned*)(lp + MISC_OFF), wid); }
}
__device__ __forceinline__ void ph_outproj(int l, LAS unsigned char* lds, int wid, SLICE_ARGS) {
    SLICE_PRE();
    pg8::Gemm g{ws + WS_MERGED, (const bf16*)(ws + WS_WOUT) + (size_t)l * 1024 * 1024, 16, 2048, 2048, nullptr};
    pg8::StaticOrder S; S.init(npm, pm0, DM, Gl, Bl, loc);
    EpiResid E{(l == 0) ? a->in[I_X] : nullptr, (const bf16*)(ws + WS_XR), (bf16*)(ws + WS_XR), (const float*)(ws + WS_MOD) + (size_t)l * 8 * 6144 + 2048};
    pg8::gemm_phase<EpiResid, pg8::StaticOrder, false>(lds, g, S, E, wid);
}
__device__ __forceinline__ void ph_gu_dense(int l, LAS unsigned char* lds, int wid, SLICE_ARGS) {
    SLICE_PRE();
    pg8::Gemm g{ws + WS_H, ws + WS_WGU, 16, 2048, 2048, nullptr};
    pg8::StaticOrder S; S.init(npm, pm0, 2 * FFD, Gl, Bl, loc);
    EpiGU E{(bf16*)(ws + WS_ACT), FFD};
    pg8::gemm_phase<EpiGU, pg8::StaticOrder, false>(lds, g, S, E, wid);
    if (2 * Bl >= Gl) moe_convert(a, lds, wid, CONV_QUOTA);
}
__device__ __forceinline__ void ph_down_dense(int l, LAS unsigned char* lds, int wid, SLICE_ARGS) {
    SLICE_PRE();
    pg8::Gemm g{ws + WS_ACT, ws + WS_WDN, FFD / 64, FFD * 2, FFD * 2, nullptr};
    pg8::StaticOrder S; S.init(npm, pm0, DM, Gl, Bl, loc);
    EpiResid E{nullptr, (const bf16*)(ws + WS_XR), (bf16*)(ws + WS_XR), (const float*)(ws + WS_MOD) + (size_t)l * 8 * 6144 + 5120};
    pg8::gemm_phase<EpiResid, pg8::StaticOrder, false>(lds, g, S, E, wid);
}
__device__ __forceinline__ void ph_gu_moe(int l, LAS unsigned char* lds, int wid, int Gx, int Bx) {
    PHASE_PRE();
    LAS unsigned char* lp = lds; asm volatile("" : "+s"(lp));
    volatile LAS int* tab = (volatile LAS int*)(lp + MISC_OFF + 64);
    moe_tables(tab, (const unsigned*)(ws + WS_CTL) + CW_CNT, 2 * FFE / 256, wid);
    pg8::Gemm g{ws + WS_HS8, ws + WS_MGU, 8, 1024, 1024, nullptr};
    MoeOrder S{tab, Gl, Bl, 2 * FFE / 256, 0, 1 << 30};
    EpiGU8 E{(fp8*)(ws + WS_ACT8), FFE};
    pg8::gemm_phase<EpiGU8, MoeOrder, false, true>(lds, g, S, E, wid);
}
__device__ __forceinline__ void ph_down_moe(int l, LAS unsigned char* lds, int wid, int Gx, int Bx) {
    PHASE_PRE();
    LAS unsigned char* lp = lds; asm volatile("" : "+s"(lp));
    volatile LAS int* tab = (volatile LAS int*)(lp + MISC_OFF + 64);
    moe_tables(tab, (const unsigned*)(ws + WS_CTL) + CW_CNT, DM / 256, wid);
    pg8::Gemm g{ws + WS_ACT8, ws + WS_MDN, FFE / 128, FFE, FFE, nullptr};
    const int lim = 2 * Gl;
    MoeOrder S{tab, Gl, Bl, DM / 256, 1, lim};
    EpiMoeDown E{(bf16*)(ws + WS_XR), (bf16*)(ws + WS_Y1), (const float*)(ws + WS_MOD) + (size_t)l * 8 * 6144 + 5120, (const int*)(ws + WS_PERM), (const float*)(ws + WS_TW)};
    pg8::gemm_phase<EpiMoeDown, MoeOrder, false, true>(lds, g, S, E, wid);
    MoeOrder S2{tab, Gl, Bl, DM / 256, 2, lim};
    EpiMoeDownT<1> E2{E.x, E.y1, E.gate, E.perm, E.tw};
    pg8::gemm_phase<EpiMoeDownT<1>, MoeOrder, false, true, 1>(lds, g, S2, E2, wid);
}

constexpr int NPHASE = 18;
#ifndef PH_MASK
#define PH_MASK 0x3FFFF
#endif
#ifndef BISECT_GLOBAL_SEAMS
#define BISECT_GLOBAL_SEAMS 0
#endif
#ifndef LOCAL_MODE
#define LOCAL_MODE 1
#endif
#ifndef REP_MASK
#define REP_MASK 0
#endif
__global__ void __launch_bounds__(NTHREADS, 2) fwd_kernel(Args a_by_value_unused) {
    extern __shared__ __attribute__((aligned(16))) unsigned char lds_raw[];
    LAS unsigned char* lds = (LAS unsigned char*)lds_raw;
    volatile LAS unsigned* MISC0 = (volatile LAS unsigned*)(lds + MISC_OFF);
#define MISC (__extension__({ LAS unsigned char* p_ = lds; asm volatile("" : "+s"(p_)); (volatile LAS unsigned*)(p_ + MISC_OFF); }))
    const int Gx = grid_n(), Bx = block_i();
    const int wid = __builtin_amdgcn_readfirstlane((int)(threadIdx.x >> 6));
    {
        const int lane0 = lane_id();
        for (int u = wid * 64 + lane0; u < (LDS_BYTES - MISC_OFF) / 4; u += NTHREADS) MISC0[u] = 0u;
        __syncthreads();
    }
#if MK_MULTI
    const int lo = argp()->ph_lo, hi = argp()->ph_hi;
#define IN(k) (((PH_MASK >> (k)) & 1) && lo <= (k) && (k) < hi)
#define SEAM(k) do { } while (0)
#define SEAMX() do { } while (0)
#else
    xcd_barrier_post((unsigned*)(argp()->ws + WS_CTL) + CW_BAR, wid, MISC0);
#define IN(k) ((PH_MASK >> (k)) & 1)
#define SEAM(k) do { xcd_barrier((unsigned*)(argp()->ws + WS_CTL) + CW_BAR, MISC, wid); } while (0)
#define SEAMX() xcd_barrier((unsigned*)(argp()->ws + WS_CTL) + CW_BAR, MISC, wid)
#endif
#if MK_MULTI
#define SEAML(k) do { } while (0)
#else
#define SEAML(k) do { if (loc && !(BISECT_GLOBAL_SEAMS)) xcd_local_barrier((unsigned*)(argp()->ws + WS_CTL) + CW_BAR, MISC, wid); else xcd_barrier((unsigned*)(argp()->ws + WS_CTL) + CW_BAR, MISC, wid); } while (0)
#endif
#define REP(k) (((REP_MASK) >> (k)) & 1)

    if (IN(0)) { prologue(argp(), lds, wid, Gx, Bx); }
    if (REP(0)) { SEAMX(); prologue(argp(), lds, wid, Gx, Bx); }
    int loc = 0, Gs = Gx, Bs = Bx, pm0s = 0, npms = T / 256, xq = 0, norm_done0 = 0;
#if !MK_MULTI && LOCAL_MODE && (REP_MASK) == 0
    xcd_barrier_arrive((unsigned*)(argp()->ws + WS_CTL) + CW_BAR, MISC, wid);
    __syncthreads();
    { volatile LAS unsigned* m_ = MISC;
      if (__builtin_amdgcn_readfirstlane((int)m_[2]) != 0) { loc = 1; xq = (int)(xb_xcc_id() & 7u); Gs = __builtin_amdgcn_readfirstlane((int)m_[0]); Bs = __builtin_amdgcn_readfirstlane((int)m_[3]); pm0s = 8 * xq; npms = 8; } }
    if (loc && Gs == 32 && IN(1)) { norm1_l0_split(argp(), lds, wid, Gs, Bs, pm0s, npms); norm_done0 = 1; }
    else xcd_barrier_wait((unsigned*)(argp()->ws + WS_CTL) + CW_BAR, MISC, wid);
#else
    SEAM(0);
#endif
#define SLICE Gs, Bs, pm0s, npms, loc
#define WHOLE Gx, Bx, 0, T / 256, 0
    for (int l = 0; l < DEPTH; ++l) {
        const int pb = 1 + 8 * l;
        if (IN(pb + 0) && !(l == 0 && norm_done0)) ph_norm1(l, lds, wid, SLICE);
        if (REP(pb + 0)) { SEAMX(); ph_norm1(l, lds, wid, WHOLE); }
        SEAML(pb + 0);
        if (IN(pb + 1)) ph_inproj(l, lds, wid, SLICE);
        if (REP(pb + 1)) { SEAMX(); ph_norm1(l, lds, wid, WHOLE); SEAMX(); ph_inproj(l, lds, wid, WHOLE); }
        SEAML(pb + 1);
        if (IN(pb + 2)) ph_up(l, lds, wid, SLICE);
        if (REP(pb + 2)) { SEAMX(); ph_up(l, lds, wid, WHOLE); }
        if (loc) xcd_local_arrive((unsigned*)(argp()->ws + WS_CTL) + CW_BAR, MISC, wid); else SEAM(pb + 2);
        if (IN(pb + 3)) ph_attn(l, 0, lds, wid, loc, xq, loc);
        if (REP(pb + 3)) { SEAMX(); ph_attn(l, 1, lds, wid, 0, 0, 0); }
        SEAML(pb + 3);
        if (IN(pb + 4)) ph_outproj(l, lds, wid, SLICE);
        if (REP(pb + 4) && l == 0) { SEAMX(); ph_outproj(l, lds, wid, WHOLE); }
        if (l == DEPTH - 1 && IN(pb + 4)) { PHASE_PRE(); (void)Gl; (void)Bl; moe_convert(a, lds, wid, 1 << 20); }
        if (l == DEPTH - 1) { if (loc) { xcd_local_barrier((unsigned*)(argp()->ws + WS_CTL) + CW_BAR, MISC, wid); xcd_barrier_arrive((unsigned*)(argp()->ws + WS_CTL) + CW_BAR, MISC, wid); } else SEAM(pb + 4); }
        else SEAML(pb + 4);
        if (l == 0) {
            if (IN(pb + 5)) { PHASE_PRE(); norm_phase<1>(a, l, nullptr, lds, wid, Gs, Bs, pm0s, npms); (void)Gl; (void)Bl; }
            if (REP(pb + 5)) { SEAMX(); PHASE_PRE(); norm_phase<1>(a, l, nullptr, lds, wid, Gl, Bl, 0, T / 256); }
            SEAML(pb + 5);
            if (IN(pb + 6)) ph_gu_dense(l, lds, wid, SLICE);
            if (REP(pb + 6)) { SEAMX(); ph_gu_dense(l, lds, wid, WHOLE); }
            SEAML(pb + 6);
            if (IN(pb + 7)) ph_down_dense(l, lds, wid, SLICE);
            SEAML(pb + 7);
        } else {
            if (IN(pb + 5)) { PHASE_PRE(); norm_phase<2>(a, l, nullptr, lds, wid, Gs, Bs, pm0s, npms, loc); (void)Gl; (void)Bl; }
            SEAM(pb + 5);
            const int Bm = loc ? xq * Gs + Bs : Bx;
            if (IN(pb + 6)) ph_gu_moe(l, lds, wid, Gx, Bm);
            if (REP(pb + 6)) { SEAMX(); ph_gu_moe(l, lds, wid, Gx, Bx); }
            SEAM(pb + 6);
            if (IN(pb + 7)) ph_down_moe(l, lds, wid, Gx, Bm);
            SEAM(pb + 7);
        }
    }
    if (IN(17)) { PHASE_PRE(); norm_phase<3>(a, 0, nullptr, lds, wid, Gl, Bl, 0, T / 256); }
#undef SLICE
#undef WHOLE
#undef SEAML
#undef IN
#undef SEAM
#undef SEAMX
#undef REP
#undef MISC
}

extern "C" void kernel_launch(void* const* d_in, const int* in_sizes, int n_in, void* d_out, int out_size, void* d_ws, size_t ws_size, hipStream_t stream) {
    static int grid = 0;
    if (grid == 0) {
        if (n_in != 24 || out_size != T * DM || ws_size < WS_END) { fprintf(stderr, "kernel_launch: unexpected shapes (n_in %d, out %d, ws %zu)\n", n_in, out_size, ws_size); grid = -1; return; }
        int dev = 0, cus = 0;
        if (hipGetDevice(&dev) != hipSuccess || hipDeviceGetAttribute(&cus, hipDeviceAttributeMultiprocessorCount, dev) != hipSuccess) { grid = -1; return; }
        if (hipFuncSetAttribute((const void*)fwd_kernel, hipFuncAttributeMaxDynamicSharedMemorySize, LDS_BYTES) != hipSuccess) { fprintf(stderr, "kernel_launch: hipFuncSetAttribute failed\n"); grid = -1; return; }
        int per_cu = 0;
        if (hipOccupancyMaxActiveBlocksPerMultiprocessor(&per_cu, (const void*)fwd_kernel, NTHREADS, LDS_BYTES) != hipSuccess || per_cu < 1) fprintf(stderr, "kernel_launch: occupancy query reports %d\n", per_cu);
        (void)hipGetLastError();
        grid = cus;
    }
    if (grid < 0) return;
    if (hipMemsetAsync((char*)d_ws + WS_CTL, 0, CTL_ZERO_BYTES, stream) != hipSuccess) return;
    Args a{};
    for (int i = 0; i < 24; ++i) a.in[i] = (const float*)d_in[i];
    a.out = (float*)d_out; a.ws = (unsigned char*)d_ws;
#if MK_MULTI
    for (int ph = 0; ph < NPHASE; ++ph) { a.ph_lo = ph; a.ph_hi = ph + 1; hipLaunchKernelGGL(fwd_kernel, dim3(grid), dim3(NTHREADS), LDS_BYTES, stream, a); }
#else
    a.ph_lo = 0; a.ph_hi = NPHASE;
    hipLaunchKernelGGL(fwd_kernel, dim3(grid), dim3(NTHREADS), LDS_BYTES, stream, a);
#endif
}
```

```cpp
#include <hip/hip_runtime.h>
#include <cstdio>
#include <cstdint>

#define LAS __attribute__((address_space(3)))
#define GAS __attribute__((address_space(1)))
typedef unsigned short bf16;
typedef short bf16x8 __attribute__((ext_vector_type(8)));
typedef short s16x4 __attribute__((ext_vector_type(4)));
typedef float f32x4 __attribute__((ext_vector_type(4)));
typedef float f32x2 __attribute__((ext_vector_type(2)));
typedef float f32x16 __attribute__((ext_vector_type(16)));
typedef unsigned u32x4 __attribute__((ext_vector_type(4)));
typedef unsigned u32x2 __attribute__((ext_vector_type(2)));
typedef int i32x4 __attribute__((ext_vector_type(4)));
typedef int i32x8 __attribute__((ext_vector_type(8)));
typedef unsigned char fp8;

#ifndef MK_MULTI
#define MK_MULTI 0
#endif

constexpr int DM = 1024, NB = 8, SEQ = 2048, T = NB * SEQ, DEPTH = 2;
constexpr int INW = 2342, NIN = 2560;
constexpr int FFD = 2816, NEXP = 8, FFE = 3584;
constexpr int NWAVES = 8, NTHREADS = 512;
constexpr float EPS = 1e-6f;
constexpr float LOG2E = 1.4426950408889634f;
constexpr float C_DIFF = 0.25503486164919736f;
constexpr float C_FOX = 0.18033688011112042f;
constexpr float C_MLA = 0.14724444602590306f;

constexpr size_t MiB = 1u << 20;
constexpr size_t WS_CTL = 0, CTL_ZERO_BYTES = 66 * 1024;
constexpr size_t WS_MOD = 1 * MiB;
constexpr size_t WS_COS = 1 * MiB + 512 * 1024;
constexpr size_t WS_SIN = WS_COS + 128 * 1024;
constexpr size_t WS_SSQ = 2 * MiB;
constexpr size_t WS_SSKV = WS_SSQ + 64 * 1024;
constexpr size_t WS_TW = WS_SSKV + 64 * 1024;
constexpr size_t WS_SSP = 3 * MiB;
constexpr size_t WS_FB = 3 * MiB;
constexpr size_t WS_PERM = 4 * MiB;
constexpr size_t WS_MODP = 5 * MiB;
constexpr size_t WS_WIN = 8 * MiB;
constexpr size_t WS_WOUT = 18 * MiB;
constexpr size_t WS_WUP = 22 * MiB;
constexpr size_t WS_WGU = 24 * MiB;
constexpr size_t WS_WDN = 35 * MiB;
constexpr size_t WS_MGU = 41 * MiB;
constexpr size_t WS_MDN = 97 * MiB;
constexpr size_t WS_H = 434 * MiB;
constexpr size_t WS_DQ = 241 * MiB, WS_DK = 249 * MiB, WS_DV = 257 * MiB;
constexpr size_t WS_FQ = 265 * MiB, WS_FK = 277 * MiB, WS_FV = 289 * MiB;
constexpr size_t WS_CQKV = 301 * MiB;
constexpr size_t WS_MISC = 317 * MiB;
constexpr size_t WS_MQ = 321 * MiB, WS_MK = 339 * MiB, WS_MV = 357 * MiB;
constexpr size_t WS_MERGED = 369 * MiB;
constexpr size_t WS_ACT = 125 * MiB;
constexpr size_t WS_ACT8 = 253 * MiB;
constexpr size_t WS_Y1 = 8 * MiB;
constexpr size_t WS_FK2 = 466 * MiB;
constexpr size_t WS_HS8 = 125 * MiB;
constexpr size_t WS_XR = 402 * MiB;
constexpr size_t WS_END = 482 * MiB;
constexpr int CW_TMO = 0, CW_BAR = 4096, CW_ATTQ = 8192, CW_CNT = 8448, CW_PANEL = 9216, CW_CONVQ = 16384;

constexpr int RING_BYTES = 131072;
constexpr int MISC_OFF = RING_BYTES;
constexpr int LDS_BYTES = 147456;

#define RLX_AGENT __ATOMIC_RELAXED, __HIP_MEMORY_SCOPE_AGENT
#define LDS_WAIT() asm volatile("s_waitcnt lgkmcnt(0)" ::: "memory")
#define VM_WAIT() asm volatile("s_waitcnt vmcnt(0)" ::: "memory")
__device__ __forceinline__ unsigned cvt_pk_bf16(float lo, float hi) { unsigned r; asm volatile("v_cvt_pk_bf16_f32 %0, %1, %2" : "=v"(r) : "v"(lo), "v"(hi)); return r; }
__device__ __forceinline__ float bf2f(bf16 v) { return __uint_as_float(((unsigned)v) << 16); }
__device__ __forceinline__ int lane_id() { int l; asm volatile("v_mbcnt_lo_u32_b32 %0, -1, 0\n\tv_mbcnt_hi_u32_b32 %0, -1, %0" : "=v"(l)); return l; }
template <int X> __device__ __forceinline__ float xor_lane(float v) {
    const int l = lane_id(); return __uint_as_float((unsigned)__builtin_amdgcn_ds_bpermute((l ^ X) << 2, (int)__float_as_uint(v)));
}
__device__ __forceinline__ float half_swap_sum(float v) { return v + xor_lane<32>(v); }
template <int CTRL> __device__ __forceinline__ float dpp_f(float v) { return __uint_as_float((unsigned)__builtin_amdgcn_update_dpp(0, (int)__float_as_uint(v), CTRL, 0xF, 0xF, true)); }
__device__ __forceinline__ float sum16_dpp(float v) { v += dpp_f<0xB1>(v); v += dpp_f<0x4E>(v); v += dpp_f<0x141>(v); v += dpp_f<0x140>(v); return v; }
__device__ __forceinline__ float sum32_dpp(float v) { v = sum16_dpp(v); auto rr = __builtin_amdgcn_permlane16_swap(__float_as_uint(v), __float_as_uint(v), false, false); return __uint_as_float(rr[0]) + __uint_as_float(rr[1]); }
__device__ __forceinline__ float wave_sum(float v) {
    v = sum32_dpp(v); auto rr = __builtin_amdgcn_permlane32_swap(__float_as_uint(v), __float_as_uint(v), false, false); return __uint_as_float(rr[0]) + __uint_as_float(rr[1]);
}
__device__ __forceinline__ const void* uniform_ptr(const void* p) { const unsigned long long v = (unsigned long long)p;
    const unsigned lo = __builtin_amdgcn_readfirstlane((unsigned)v), hi = __builtin_amdgcn_readfirstlane((unsigned)(v >> 32)); return (const void*)(((unsigned long long)hi << 32) | lo); }
__device__ __forceinline__ void glds16(const void* sbase_, unsigned voff, unsigned lds_dst_) { unsigned keep; const void* sbase = uniform_ptr(sbase_); const unsigned lds_dst = __builtin_amdgcn_readfirstlane(lds_dst_);
    asm volatile("s_mov_b32 %0, m0\n\ts_mov_b32 m0, %3\n\ts_nop 0\n\tglobal_load_lds_dwordx4 %1, %2\n\ts_mov_b32 m0, %0" : "=&s"(keep) : "v"(voff), "s"(sbase), "s"(lds_dst) : "memory"); }
__device__ __forceinline__ void glds4(const void* sbase_, unsigned voff, unsigned lds_dst_) { unsigned keep; const void* sbase = uniform_ptr(sbase_); const unsigned lds_dst = __builtin_amdgcn_readfirstlane(lds_dst_);
    asm volatile("s_mov_b32 %0, m0\n\ts_mov_b32 m0, %3\n\ts_nop 0\n\tglobal_load_lds_dword %1, %2\n\ts_mov_b32 m0, %0" : "=&s"(keep) : "v"(voff), "s"(sbase), "s"(lds_dst) : "memory"); }
__device__ __forceinline__ int grid_n() { return __builtin_amdgcn_readfirstlane((int)gridDim.x); }
__device__ __forceinline__ int block_i() { return __builtin_amdgcn_readfirstlane((int)blockIdx.x); }
__device__ __forceinline__ f32x4 zero4_asm() { float a, b, c, d; asm volatile("v_mov_b32 %0, 0\n\tv_mov_b32 %1, 0\n\tv_mov_b32 %2, 0\n\tv_mov_b32 %3, 0" : "=v"(a), "=v"(b), "=v"(c), "=v"(d)); return (f32x4){a, b, c, d}; }
__device__ __forceinline__ f32x16 zero16_asm() { const f32x4 a = zero4_asm(), b = zero4_asm(), c = zero4_asm(), d = zero4_asm();
    return (f32x16){a[0], a[1], a[2], a[3], b[0], b[1], b[2], b[3], c[0], c[1], c[2], c[3], d[0], d[1], d[2], d[3]}; }
__device__ __forceinline__ u32x4 zero4u_asm() { return __builtin_bit_cast(u32x4, zero4_asm()); }
__device__ __forceinline__ float fexp2(float x) { return __builtin_amdgcn_exp2f(x); }
__device__ __forceinline__ float frcp(float x) { return __builtin_amdgcn_rcpf(x); }
__device__ __forceinline__ float silu_f(float g) { return g * frcp(1.f + fexp2(-g * LOG2E)); }

#define XB_TMO      128
#define XB_XCNT(j)  (256  + 64 * (j))
#define XB_XSUB(j)  (1280 + 64 * (j))
#define XB_XGEN(j)  (2304 + 64 * (j))
#define XB_TOP      3328
#define XB_TOPGEN   3392
#define XCD_BAR_WORDS 3456
#define XB_LSUB(j)  (3456 + 32 * (j))
#define XB_LGEN(j)  (3712 + 32 * (j))
#define XB_SPIN_CAP (1u << 18)
__device__ __forceinline__ unsigned xb_ld(unsigned* p)              { return __hip_atomic_load(p, __ATOMIC_RELAXED, __HIP_MEMORY_SCOPE_AGENT); }
__device__ __forceinline__ unsigned xb_add(unsigned* p, unsigned v) { return __hip_atomic_fetch_add(p, v, __ATOMIC_RELAXED, __HIP_MEMORY_SCOPE_AGENT); }
__device__ __forceinline__ unsigned xb_xcc_id() { return (unsigned)__builtin_amdgcn_s_getreg((3 << 11) | 20) & 0xFu; }
#define XB_SPIN(cond, bar) do { unsigned _sp = 0; while (cond) { __builtin_amdgcn_s_sleep(1); \
    if ((++_sp & 255u) == 0u) { if (xb_ld(&(bar)[XB_TMO])) break; if (_sp > XB_SPIN_CAP) { atomicAdd(&(bar)[XB_TMO], 1u); break; } } } } while (0)
struct XcdBarrier { unsigned* bar; unsigned x; volatile LAS unsigned* st; };
__device__ __forceinline__ void xcd_barrier_post(unsigned* bar, int wid, volatile LAS unsigned* st) {
    if (wid == 0 && lane_id() == 0) st[3] = xb_add(&bar[XB_XCNT(xb_xcc_id())], 1u);
}
__device__ __forceinline__ void xcd_barrier_complete(unsigned* bar, unsigned x, unsigned& nloc, unsigned& nx, unsigned& uni) {
    const unsigned G = (unsigned)grid_n();
    unsigned sum, cnt, mine, bad, sp = 0u;
    for (;;) {
        sum = 0u; cnt = 0u; mine = 0u; bad = 0u;
#pragma unroll
        for (unsigned j = 0; j < 16; ++j) { const unsigned c = xb_ld(&bar[XB_XCNT(j)]); sum += c; cnt += (c > 0u) ? 1u : 0u; mine = (j == x) ? c : mine; bad += (c != 0u && (c * 8u != G || j >= 8u)) ? 1u : 0u; }
        if (sum == G) break;
        __builtin_amdgcn_s_sleep(1);
        if ((++sp & 255u) == 0u) { if (xb_ld(&bar[XB_TMO])) break; if (sp > XB_SPIN_CAP) { atomicAdd(&bar[XB_TMO], 1u); break; } }
    }
    nloc = mine > 0u ? mine : 1u; nx = cnt > 0u ? cnt : 1u;
    uni = (sum == G && cnt == 8u && bad == 0u && G >= 64u) ? 1u : 0u;
}
__device__ __forceinline__ void xcd_barrier(unsigned* bar_, volatile LAS unsigned* st_, int wid) {
    XcdBarrier b; b.bar = bar_; b.x = xb_xcc_id(); b.st = st_;
    asm volatile("s_waitcnt vmcnt(0)" ::: "memory");
    __syncthreads();
    if (wid == 0 && lane_id() == 0) {
        unsigned* bar = b.bar;
        __builtin_amdgcn_s_waitcnt(0);
        unsigned nloc = b.st[0], nx = b.st[1];
        if (nloc == 0u) { unsigned uni = 0u; xcd_barrier_complete(bar, b.x, nloc, nx, uni); b.st[0] = nloc; b.st[1] = nx; b.st[2] = uni; }
        const unsigned old = xb_add(&bar[XB_XSUB(b.x)], 1u);
        const unsigned gen = old / nloc;
        if (old + 1u == (gen + 1u) * nloc) {
            __builtin_amdgcn_fence(__ATOMIC_RELEASE, "agent");
            asm volatile("s_waitcnt vmcnt(0)" ::: "memory");
            const unsigned og = xb_add(&bar[XB_TOP], 1u);
            const unsigned tg = og / nx;
            if (og + 1u == (tg + 1u) * nx) xb_add(&bar[XB_TOPGEN], 1u);
            else XB_SPIN(xb_ld(&bar[XB_TOPGEN]) == tg, bar);
            __builtin_amdgcn_fence(__ATOMIC_ACQUIRE, "agent");
            xb_add(&bar[XB_XGEN(b.x)], 1u);
            asm volatile("s_waitcnt vmcnt(0)" ::: "memory");
        } else {
            XB_SPIN(xb_ld(&bar[XB_XGEN(b.x)]) == gen, bar);
            __builtin_amdgcn_fence(__ATOMIC_ACQUIRE, "agent");
            asm volatile("s_waitcnt vmcnt(0)" ::: "memory");
        }
    }
    __syncthreads();
}

__device__ __forceinline__ void xcd_local_barrier(unsigned* bar_, volatile LAS unsigned* st_, int wid) {
    asm volatile("s_waitcnt vmcnt(0)" ::: "memory");
    __syncthreads();
    if (wid == 0 && lane_id() == 0) {
        unsigned* bar = bar_; const unsigned x = xb_xcc_id(); const unsigned nloc = st_[0];
        __builtin_amdgcn_s_waitcnt(0);
        const unsigned old = xb_add(&bar[XB_LSUB(x)], 1u);
        const unsigned gen = old / nloc;
        if (old + 1u == (gen + 1u) * nloc) xb_add(&bar[XB_LGEN(x)], 1u);
        else XB_SPIN(xb_ld(&bar[XB_LGEN(x)]) == gen, bar);
        __builtin_amdgcn_fence(__ATOMIC_ACQUIRE, "agent");
        asm volatile("s_waitcnt vmcnt(0)" ::: "memory");
    }
    __syncthreads();
}

__device__ __forceinline__ void xcd_local_arrive(unsigned* bar_, volatile LAS unsigned* st_, int wid) {
    asm volatile("s_waitcnt vmcnt(0)" ::: "memory");
    __syncthreads();
    if (wid == 0 && lane_id() == 0) {
        unsigned* bar = bar_; const unsigned x = xb_xcc_id(); const unsigned nloc = st_[0];
        __builtin_amdgcn_s_waitcnt(0);
        const unsigned old = xb_add(&bar[XB_LSUB(x)], 1u);
        const unsigned gen = old / nloc;
        st_[5] = gen;
        if (old + 1u == (gen + 1u) * nloc) xb_add(&bar[XB_LGEN(x)], 1u);
    }
}
__device__ __forceinline__ void xcd_local_wait(unsigned* bar_, volatile LAS unsigned* st_, int wid) {
    if (wid == 0 && lane_id() == 0) {
        unsigned* bar = bar_; const unsigned x = xb_xcc_id(); const unsigned gen = st_[5];
        XB_SPIN(xb_ld(&bar[XB_LGEN(x)]) == gen, bar);
        __builtin_amdgcn_fence(__ATOMIC_ACQUIRE, "agent");
        asm volatile("s_waitcnt vmcnt(0)" ::: "memory");
    }
    __syncthreads();
}

__device__ __forceinline__ void xcd_barrier_arrive(unsigned* bar_, volatile LAS unsigned* st_, int wid) {
    asm volatile("s_waitcnt vmcnt(0)" ::: "memory");
    __syncthreads();
    if (wid == 0 && lane_id() == 0) {
        unsigned* bar = bar_; const unsigned x = xb_xcc_id(); unsigned nloc = st_[0], nx = st_[1];
        __builtin_amdgcn_s_waitcnt(0);
        if (nloc == 0u) { unsigned uni = 0u; xcd_barrier_complete(bar, x, nloc, nx, uni); st_[0] = nloc; st_[1] = nx; st_[2] = uni; }
        const unsigned old = xb_add(&bar[XB_XSUB(x)], 1u);
        const unsigned gen = old / nloc; unsigned role = 0u, tg = 0u;
        if (old + 1u == (gen + 1u) * nloc) {
            __builtin_amdgcn_fence(__ATOMIC_RELEASE, "agent");
            asm volatile("s_waitcnt vmcnt(0)" ::: "memory");
            const unsigned og = xb_add(&bar[XB_TOP], 1u);
            tg = og / nx; role = 1u;
            if (og + 1u == (tg + 1u) * nx) { xb_add(&bar[XB_TOPGEN], 1u); role = 2u; }
        }
        st_[7] = gen; st_[8] = tg; st_[9] = role;
    }
}
__device__ __forceinline__ void xcd_barrier_wait(unsigned* bar_, volatile LAS unsigned* st_, int wid) {
    if (wid == 0 && lane_id() == 0) {
        unsigned* bar = bar_; const unsigned x = xb_xcc_id(); const unsigned gen = st_[7], tg = st_[8], role = st_[9];
        if (role != 0u) {
            if (role == 1u) XB_SPIN(xb_ld(&bar[XB_TOPGEN]) == tg, bar);
            __builtin_amdgcn_fence(__ATOMIC_ACQUIRE, "agent");
            xb_add(&bar[XB_XGEN(x)], 1u);
            asm volatile("s_waitcnt vmcnt(0)" ::: "memory");
        } else {
            XB_SPIN(xb_ld(&bar[XB_XGEN(x)]) == gen, bar);
            __builtin_amdgcn_fence(__ATOMIC_ACQUIRE, "agent");
            asm volatile("s_waitcnt vmcnt(0)" ::: "memory");
        }
    }
    __syncthreads();
}

namespace pg8 {
constexpr int BM = 256, BK = 64, HALF = 128, HTB = HALF * BK * 2, STAGE_BYTES = 8 * HTB, NXCD = 8, WGM = 8;
__host__ __device__ __forceinline__ int lds_byte(int r, int c) { const int st = (r >> 4) * 2 + (c >> 5), rr = r & 15, cc = c & 31, ob = rr * 64 + cc * 2; return st * 1024 + (ob ^ (((ob >> 9) & 1) << 5)); }
__host__ __device__ __forceinline__ void stage_rc(int b, int& R, int& C) { const int st = b / 1024, sb = b % 1024, swz = sb ^ (((sb >> 9) & 1) << 5); R = (st >> 1) * 16 + swz / 64; C = (st & 1) * 32 + (swz % 64) / 2; }
__host__ __device__ __forceinline__ int perm32(int rho) { const int n = rho >> 4, i = rho & 15; return 8 * (i >> 2) + 4 * n + (i & 3); }

struct Unit { int arow, acolb, brow, orow, pn, nvalid, aux; };
struct Gemm { const void* A; const void* Bt; int nt, ldaB, ldbB; const int* gidx; };

struct StaticOrder {
    int nM, nN, nwg, G, c, pm0, loc;
    __device__ void init(int npm, int pm0_, int N, int G_, int c_, int loc_) { nM = npm; nN = N / BM; nwg = nM * nN; G = G_; c = c_; pm0 = pm0_; loc = loc_; }
    __device__ bool next(int i, Unit& u) const {
        const long L = (long)i * G + c; if (L >= nwg) return false;
        int pm, pn;
        if (loc) { pn = (int)L / nM; pm = (int)L - pn * nM; }
        else { int wgid = (int)L; { const int q = nwg / NXCD, r = nwg % NXCD, xcd = wgid % NXCD, off = wgid / NXCD; wgid = (xcd < r ? xcd * (q + 1) : r * (q + 1) + (xcd - r) * q) + off; }
            const int nig = WGM * nN, gid = wgid / nig, fm = gid * WGM, gsz = (nM - fm) < WGM ? (nM - fm) : WGM;
            pm = fm + ((wgid % nig) % gsz); pn = (wgid % nig) / gsz; }
        pm = __builtin_amdgcn_readfirstlane(pm + pm0); pn = __builtin_amdgcn_readfirstlane(pn);
        u.arow = pm * BM; u.acolb = 0; u.brow = pn * BM; u.orow = pm * BM; u.pn = pn; u.nvalid = BM; u.aux = 0; return true;
    }
};

template <class Epi, class Sched, bool GATHER, bool FP8 = false, int NB = 2>
__device__ __forceinline__ void gemm_phase(LAS unsigned char* lds_in, const Gemm g, const Sched& S, const Epi& E, int wid_in) {
    LAS unsigned char* lds = lds_in; int wid = wid_in; asm volatile("" : "+s"(lds), "+s"(wid));
    int lane_ = lane_id(); asm volatile("" : "+v"(lane_));
    const int lane = lane_, tid = wid * 64 + lane, wr = wid >> 2, wc = wid & 3, fr = lane & 15, fq = lane >> 4;
    const int nt = g.nt;
    unsigned voffA[2], voffB[2]; int RA[2]; unsigned CA2[2];
#pragma unroll
    for (int i = 0; i < 2; ++i) { int R, C; stage_rc(tid * 16 + i * 8192, R, C); const int Rb = Epi::PERM ? ((R & ~31) + perm32(R & 31)) : R;
        voffA[i] = (unsigned)(R * g.ldaB + C * 2); voffB[i] = (unsigned)(Rb * g.ldbB + C * 2); RA[i] = R; CA2[i] = (unsigned)C * 2u; }
    const size_t kstep = (size_t)(BK * 2);
    const size_t hstepA = (size_t)HALF * g.ldaB, hstepB = (size_t)HALF * g.ldbB;
    const unsigned ldsw = (unsigned)wid * 1024u, ldsbase = (unsigned)(uintptr_t)lds;
    const int aoff = lds_byte(wr * 64 + fr, fq * 8), boff = lds_byte(wc * 32 + fr, fq * 8);
#define PG8_SA(b, h) (((b) * 2 + (h)) * HTB)
#define PG8_SB(b, h) ((4 + (b) * 2 + (h)) * HTB)
#define PG8_STAGE(bufoff, gbase, voff) do { _Pragma("unroll") for (int _i = 0; _i < 2; ++_i) \
        glds16((const void*)(gbase), (voff)[_i], ldsbase + (unsigned)(bufoff) + ldsw + _i * 8192u); } while (0)
#define PG8_STAGE_A(bufoff, gbase, h, OFFS) do { if constexpr (GATHER) { unsigned go_[2]; _Pragma("unroll") for (int _j = 0; _j < 2; ++_j) go_[_j] = ((OFFS[_j] >> (16 * (h))) & 0xFFFFu) * (unsigned)g.ldaB + CA2[_j]; \
        PG8_STAGE(bufoff, gbase, go_); } else { PG8_STAGE(bufoff, (gbase) + (h) * hstepA, voffA); } } while (0)
#define PG8_LDA(dst, b, h) do { _Pragma("unroll") for (int m = 0; m < 4; ++m) _Pragma("unroll") for (int k = 0; k < 2; ++k) dst[m][k] = *(const LAS bf16x8*)(lds + PG8_SA(b, h) + aoff + m * 2048 + k * 1024); } while (0)
#define PG8_LDB(dst, b, h) do { _Pragma("unroll") for (int n = 0; n < 2; ++n) _Pragma("unroll") for (int k = 0; k < 2; ++k) dst[n][k] = *(const LAS bf16x8*)(lds + PG8_SB(b, h) + boff + n * 2048 + k * 1024); } while (0)
#define PG8_CAT(x0, x1) __builtin_shufflevector(__builtin_bit_cast(i32x4, x0), __builtin_bit_cast(i32x4, x1), 0, 1, 2, 3, 4, 5, 6, 7)
#define PG8_MMA(ai, bj, At, Bt) do { __builtin_amdgcn_s_setprio(1); \
        if constexpr (FP8) { _Pragma("unroll") for (int m = 0; m < 4; ++m) _Pragma("unroll") for (int n = 0; n < 2; ++n) \
            acc[ai][bj][m][n] = __builtin_amdgcn_mfma_scale_f32_16x16x128_f8f6f4(PG8_CAT(Bt[n][0], Bt[n][1]), PG8_CAT(At[m][0], At[m][1]), acc[ai][bj][m][n], 0, 0, 0, (int)Epi::SCALE_B, 0, 0x7F7F7F7F); } \
        else { _Pragma("unroll") for (int m = 0; m < 4; ++m) _Pragma("unroll") for (int n = 0; n < 2; ++n) _Pragma("unroll") for (int k = 0; k < 2; ++k) \
            acc[ai][bj][m][n] = __builtin_amdgcn_mfma_f32_16x16x32_bf16(Bt[n][k], At[m][k], acc[ai][bj][m][n], 0, 0, 0); } \
        __builtin_amdgcn_s_setprio(0); } while (0)
#define PG8_WAIT_V(n) asm volatile("s_waitcnt vmcnt(" #n ")" ::: "memory")
#define PG8_WAIT_L(n) asm volatile("s_waitcnt lgkmcnt(" #n ")" ::: "memory")
#define PG8_BAR __builtin_amdgcn_s_barrier()
#define PG8_SCHED __builtin_amdgcn_sched_barrier(0)
#define PG8_GOFF(dst, U) do { int t_ = tid; asm volatile("" : "+v"(t_)); unsigned _t[2][2]; const int nvm1_ = (U).nvalid - 1; \
        _Pragma("unroll") for (int _i = 0; _i < 2; ++_i) { int R_, C_; stage_rc(t_ * 16 + _i * 8192, R_, C_); \
            _Pragma("unroll") for (int _h = 0; _h < 2; ++_h) { const int _r = _h * HALF + R_; _t[_h][_i] = (unsigned)g.gidx[(U).arow + (_r < nvm1_ ? _r : nvm1_)]; } } \
        _Pragma("unroll") for (int _i = 0; _i < 2; ++_i) dst[_i] = (_t[0][_i] & 0xFFFFu) | (_t[1][_i] << 16); } while (0)
    Unit cur, nxt; int ui = 0;
    if (!S.next(0, cur)) return;
    f32x4 acc[2][2][4][2];
#pragma unroll
    for (int a = 0; a < 2; ++a)
#pragma unroll
        for (int b = 0; b < 2; ++b)
#pragma unroll
            for (int m = 0; m < 4; ++m)
#pragma unroll
                for (int n = 0; n < 2; ++n) acc[a][b][m][n] = (f32x4){0.f, 0.f, 0.f, 0.f};
    bf16x8 At[4][2], B0[2][2], B1[2][2];
    unsigned co[2], no[2], so[2];
#pragma unroll
    for (int i = 0; i < 2; ++i) { co[i] = 0u; no[i] = 0u; so[i] = 0u; }
    if constexpr (GATHER) { PG8_GOFF(co, cur); }
    const char* cA = GATHER ? ((const char*)g.A + cur.acolb) : ((const char*)g.A + (size_t)cur.arow * g.ldaB + cur.acolb);
    const char* cB = (const char*)g.Bt + (size_t)cur.brow * g.ldbB;
    PG8_STAGE(PG8_SB(0, 0), cB, voffB); PG8_STAGE(PG8_SB(0, 1), cB + hstepB, voffB); PG8_STAGE_A(PG8_SA(0, 0), cA, 0, co); PG8_STAGE_A(PG8_SA(0, 1), cA, 1, co);
    if (wr == 1) PG8_BAR;
    PG8_WAIT_V(2); PG8_BAR;
    PG8_STAGE(PG8_SB(1, 0), cB + kstep, voffB); PG8_STAGE_A(PG8_SA(1, 0), cA + kstep, 0, co); PG8_STAGE(PG8_SB(1, 1), cB + hstepB + kstep, voffB);
    PG8_WAIT_V(6); PG8_BAR;
    for (;;) {
        const bool has_next = S.next(ui + 1, nxt);
        const char* nA = cA; const char* nB = cB;
        if (has_next) { nA = GATHER ? ((const char*)g.A + nxt.acolb) : ((const char*)g.A + (size_t)nxt.arow * g.ldaB + nxt.acolb); nB = (const char*)g.Bt + (size_t)nxt.brow * g.ldbB; }
        if constexpr (GATHER) {
            if (has_next) { PG8_GOFF(no, nxt); }
            else { no[0] = co[0]; no[1] = co[1]; }
        }
        for (int t = 0; t < nt; t += 2) {
            const bool last = (t == nt - 2);
            const char* a1 = cA + (size_t)(t + 1) * kstep;
            const char* a2 = last ? nA : cA + (size_t)(t + 2) * kstep; const char* b2 = last ? nB : cB + (size_t)(t + 2) * kstep;
            const char* a3 = a2 + kstep; const char* b3 = b2 + kstep;
            if constexpr (GATHER) { so[0] = last ? no[0] : co[0]; so[1] = last ? no[1] : co[1]; }
            PG8_LDB(B0, 0, 0); if (NB == 2) PG8_LDB(B1, 0, 1); PG8_SCHED; PG8_LDA(At, 0, 0); PG8_STAGE_A(PG8_SA(1, 1), a1, 1, co);
            PG8_WAIT_V(8); PG8_WAIT_L(0); PG8_BAR; PG8_MMA(0, 0, At, B0); if (NB == 2) PG8_MMA(0, 1, At, B1); PG8_BAR; PG8_SCHED;
            PG8_LDA(At, 0, 1); PG8_STAGE(PG8_SB(0, 0), b2, voffB); PG8_STAGE(PG8_SB(0, 1), b2 + hstepB, voffB); PG8_STAGE_A(PG8_SA(0, 0), a2, 0, so);
            PG8_WAIT_V(8); PG8_WAIT_L(0); PG8_BAR; PG8_MMA(1, 0, At, B0); if (NB == 2) PG8_MMA(1, 1, At, B1); PG8_BAR; PG8_SCHED;
            PG8_LDB(B0, 1, 0); if (NB == 2) PG8_LDB(B1, 1, 1); PG8_SCHED; PG8_LDA(At, 1, 0); PG8_STAGE_A(PG8_SA(0, 1), a2, 1, so);
            PG8_WAIT_V(8); PG8_WAIT_L(0); PG8_BAR; PG8_MMA(0, 0, At, B0); if (NB == 2) PG8_MMA(0, 1, At, B1); PG8_BAR; PG8_SCHED;
            PG8_LDA(At, 1, 1); PG8_STAGE(PG8_SB(1, 0), b3, voffB); PG8_STAGE(PG8_SB(1, 1), b3 + hstepB, voffB); PG8_STAGE_A(PG8_SA(1, 0), a3, 0, so);
            PG8_WAIT_V(8); PG8_WAIT_L(0); PG8_BAR; PG8_MMA(1, 0, At, B0); if (NB == 2) PG8_MMA(1, 1, At, B1); PG8_BAR; PG8_SCHED;
        }
        if (wr == 0) PG8_BAR;
        { const int ln_ = lane_id();
          E(acc, cur, wr, wc, ln_ & 15, ln_ >> 4); }
        if (!has_next) break;
#pragma unroll
        for (int a = 0; a < 2; ++a)
#pragma unroll
            for (int b = 0; b < 2; ++b)
#pragma unroll
                for (int m = 0; m < 4; ++m)
#pragma unroll
                    for (int n = 0; n < 2; ++n) acc[a][b][m][n] = (f32x4){0.f, 0.f, 0.f, 0.f};
        cur = nxt; cA = nA; cB = nB; ++ui;
        if constexpr (GATHER) { co[0] = no[0]; co[1] = no[1]; }
        if (wr == 1) PG8_BAR;
    }
    PG8_WAIT_V(0);
    PG8_BAR;
#undef PG8_SA
#undef PG8_SB
#undef PG8_STAGE
#undef PG8_STAGE_A
#undef PG8_LDA
#undef PG8_LDB
#undef PG8_MMA
#undef PG8_CAT
#undef PG8_WAIT_V
#undef PG8_WAIT_L
#undef PG8_BAR
#undef PG8_SCHED
#undef PG8_GOFF
}
}
using pg8::Unit;

struct ColDesc { int mode; bf16* dst; int pitch; float scale; const float* rs; int nrs; float rsinv; float* ss; };

__device__ __forceinline__ ColDesc desc_in(int cg, unsigned char* ws) {
    ColDesc d; d.mode = 1; d.dst = nullptr; d.pitch = 0; d.scale = 1.f; d.rs = nullptr; d.nrs = 0; d.rsinv = 0.f; d.ss = nullptr;
    if (cg < 4)       { d.dst = (bf16*)(ws + WS_DQ) + cg * 64; d.pitch = 256; d.scale = C_DIFF; }
    else if (cg < 8)  { d.dst = (bf16*)(ws + WS_DK) + (cg - 4) * 64; d.pitch = 256; }
    else if (cg < 12) { d.dst = (bf16*)(ws + WS_DV) + (cg - 8) * 64; d.pitch = 256; }
    else if (cg < 18) { d.dst = (bf16*)(ws + WS_FQ) + (cg - 12) * 64; d.pitch = 384; d.scale = C_FOX; }
    else if (cg < 24) { d.dst = (bf16*)(ws + WS_FK2) + (cg - 18) * 80; d.pitch = 480; }
    else if (cg < 30) { d.dst = (bf16*)(ws + WS_FV) + (cg - 24) * 64; d.pitch = 384; }
    else if (cg < 34) { d.mode = 4; d.dst = (bf16*)(ws + WS_CQKV) + (cg - 30) * 64; d.pitch = 512; d.ss = (float*)(ws + WS_SSP) + (cg - 30) * 2; }
    else if (cg < 36) { d.mode = 4; d.dst = (bf16*)(ws + WS_CQKV) + 256 + (cg - 34) * 64; d.pitch = 512; d.ss = (float*)(ws + WS_SSP) + 8 + (cg - 34) * 2; }
    else if (cg == 36) { d.mode = 3; }
    else d.mode = 0;
    return d;
}
__device__ __forceinline__ ColDesc desc_up(int cg, unsigned char* ws) {
    ColDesc d; d.mode = 1; d.dst = nullptr; d.pitch = 0; d.scale = 1.f; d.rs = nullptr; d.nrs = 0; d.rsinv = 0.f; d.ss = nullptr;
    if (cg < 6)       { d.dst = (bf16*)(ws + WS_MQ) + cg * 96; d.pitch = 576; d.scale = C_MLA; d.rs = (const float*)(ws + WS_SSP); d.nrs = 8; d.rsinv = 1.f / 256.f; }
    else if (cg < 9)  { d.mode = 2; d.dst = (bf16*)(ws + WS_MQ) + (2 * (cg - 6)) * 96 + 64; d.pitch = 576; d.scale = C_MLA; d.rs = (const float*)(ws + WS_SSP); d.nrs = 8; d.rsinv = 1.f / 256.f; }
    else if (cg < 12) { d.mode = 0; }
    else if (cg < 18) { d.dst = (bf16*)(ws + WS_MK) + (cg - 12) * 96; d.pitch = 576; d.rs = (const float*)(ws + WS_SSP) + 8; d.nrs = 4; d.rsinv = 1.f / 128.f; }
    else              { d.dst = (bf16*)(ws + WS_MV) + (cg - 18) * 64; d.pitch = 384; d.rs = (const float*)(ws + WS_SSP) + 8; d.nrs = 4; d.rsinv = 1.f / 128.f; }
    return d;
}

template <int WHICH> struct EpiSplit {
    static constexpr bool PERM = true; static constexpr unsigned SCALE_B = 0x7F7F7F7Fu;
    unsigned char* ws;
    const LAS float* rsl;
    __device__ __forceinline__ void operator()(const f32x4 (&acc)[2][2][4][2], const Unit& u, int wr, int wc, int fr, int fq) const {
        const float* cosT = (const float*)(ws + WS_COS); const float* sinT = (const float*)(ws + WS_SIN);
#pragma unroll
        for (int bj = 0; bj < 2; ++bj) {
            const int cg = u.pn * 4 + bj * 2 + (wc >> 1);
            const ColDesc d = (WHICH == 0) ? desc_in(cg, ws) : desc_up(cg, ws);
            const int cin = (wc & 1) * 32 + 8 * fq;
            const int row0 = u.orow + wr * 64 + fr;
            if (d.mode == 1 || d.mode == 4) {
#pragma unroll
                for (int ai = 0; ai < 2; ++ai)
#pragma unroll
                    for (int m = 0; m < 4; ++m) {
                        const int row = row0 + ai * 128 + m * 16;
                        float s = d.scale; if (d.rs) { s *= rsl[(wr * 64 + fr + ai * 128 + m * 16) * 2 + (d.nrs == 8 ? 0 : 1)]; }
                        const f32x4 v0 = acc[ai][bj][m][0] * s, v1 = acc[ai][bj][m][1] * s;
                        u32x4 w; w.x = cvt_pk_bf16(v0[0], v0[1]); w.y = cvt_pk_bf16(v0[2], v0[3]); w.z = cvt_pk_bf16(v1[0], v1[1]); w.w = cvt_pk_bf16(v1[2], v1[3]);
                        *(u32x4*)(d.dst + (size_t)row * d.pitch + cin) = w;
                        if (d.mode == 4) {
                            float q = (v0[0] * v0[0] + v0[1] * v0[1]) + (v0[2] * v0[2] + v0[3] * v0[3]) + (v1[0] * v1[0] + v1[1] * v1[1]) + (v1[2] * v1[2] + v1[3] * v1[3]);
                            { auto r16 = __builtin_amdgcn_permlane16_swap(__float_as_uint(q), __float_as_uint(q), false, false); q = __uint_as_float(r16[0]) + __uint_as_float(r16[1]);
                              auto r32 = __builtin_amdgcn_permlane32_swap(__float_as_uint(q), __float_as_uint(q), false, false); q = __uint_as_float(r32[0]) + __uint_as_float(r32[1]); }
                            if (fq == 0) d.ss[(size_t)row * 12 + (wc & 1)] = q;
                        }
                        if (WHICH == 0 || m == 3) asm volatile("" ::: "memory");
                    }
            } else if (d.mode == 2) {
                bf16* dst = d.dst + (wc & 1) * 96;
#pragma unroll
                for (int ai = 0; ai < 2; ++ai)
#pragma unroll
                    for (int m = 0; m < 4; ++m) {
                        const int row = row0 + ai * 128 + m * 16; const int pos = row & (SEQ - 1);
                        const float s = d.scale * rsl[(wr * 64 + fr + ai * 128 + m * 16) * 2];
                        const f32x4 cs = *(const f32x4*)(cosT + pos * 16 + 4 * fq), sn = *(const f32x4*)(sinT + pos * 16 + 4 * fq);
                        const f32x4 x1 = acc[ai][bj][m][0], x2 = acc[ai][bj][m][1];
                        const f32x4 o1 = (x1 * cs - x2 * sn) * s, o2 = (x1 * sn + x2 * cs) * s;
                        u32x2 w1, w2; w1.x = cvt_pk_bf16(o1[0], o1[1]); w1.y = cvt_pk_bf16(o1[2], o1[3]); w2.x = cvt_pk_bf16(o2[0], o2[1]); w2.y = cvt_pk_bf16(o2[2], o2[3]);
                        *(u32x2*)(dst + (size_t)row * d.pitch + 4 * fq) = w1;
                        *(u32x2*)(dst + (size_t)row * d.pitch + 16 + 4 * fq) = w2;
                        if (WHICH == 0 || m == 3) asm volatile("" ::: "memory");
                    }
            } else if (d.mode == 3) {
                float* dst = (float*)(ws + WS_MISC);
#pragma unroll
                for (int ai = 0; ai < 2; ++ai)
#pragma unroll
                    for (int m = 0; m < 4; ++m) {
                        const int row = row0 + ai * 128 + m * 16;
                        *(f32x4*)(dst + (size_t)row * 64 + cin) = acc[ai][bj][m][0];
                        *(f32x4*)(dst + (size_t)row * 64 + cin + 4) = acc[ai][bj][m][1];
                    }
            }
        }
    }
};

struct EpiGU {
    static constexpr bool PERM = true; static constexpr unsigned SCALE_B = 0x7F7F7F7Fu;
    bf16* act; int ldc;
    __device__ __forceinline__ void operator()(const f32x4 (&acc)[2][2][4][2], const Unit& u, int wr, int wc, int fr, int fq) const {
        const int col = u.pn * 128 + wc * 32 + 8 * fq;
#pragma unroll
        for (int ai = 0; ai < 2; ++ai)
#pragma unroll
            for (int m = 0; m < 4; ++m) {
                const int rl = ai * 128 + wr * 64 + m * 16 + fr;
                const f32x4 g0 = acc[ai][0][m][0], g1 = acc[ai][0][m][1], u0 = acc[ai][1][m][0], u1 = acc[ai][1][m][1];
                float o[8];
#pragma unroll
                for (int j = 0; j < 4; ++j) { o[j] = fexp2(g0[j] * -LOG2E); o[4 + j] = fexp2(g1[j] * -LOG2E); }
#pragma unroll
                for (int j = 0; j < 8; ++j) o[j] = frcp(1.f + o[j]);
#pragma unroll
                for (int j = 0; j < 4; ++j) { o[j] = (g0[j] * u0[j]) * o[j]; o[4 + j] = (g1[j] * u1[j]) * o[4 + j]; }
                u32x4 w; w.x = cvt_pk_bf16(o[0], o[1]); w.y = cvt_pk_bf16(o[2], o[3]); w.z = cvt_pk_bf16(o[4], o[5]); w.w = cvt_pk_bf16(o[6], o[7]);
                if (rl < u.nvalid) *(u32x4*)(act + (size_t)(u.orow + rl) * ldc + col) = w;
            }
    }
};

__device__ __forceinline__ unsigned pk4_fp8(float a, float b, float c, float d) { int w = 0; w = __builtin_amdgcn_cvt_pk_fp8_f32(a, b, w, false); w = __builtin_amdgcn_cvt_pk_fp8_f32(c, d, w, true); return (unsigned)w; }
struct EpiGU8 {
    static constexpr bool PERM = true; static constexpr unsigned SCALE_B = 0x79797979u;
    fp8* act; int ldc;
    __device__ __forceinline__ void operator()(const f32x4 (&acc)[2][2][4][2], const Unit& u, int wr, int wc, int fr, int fq) const {
        const int col = u.pn * 128 + wc * 32 + 8 * fq;
#pragma unroll
        for (int ai = 0; ai < 2; ++ai)
#pragma unroll
            for (int m = 0; m < 4; ++m) {
                const int rl = ai * 128 + wr * 64 + m * 16 + fr;
                const f32x4 g0 = acc[ai][0][m][0], g1 = acc[ai][0][m][1], u0 = acc[ai][1][m][0], u1 = acc[ai][1][m][1];
                float o[8];
#pragma unroll
                for (int j = 0; j < 4; ++j) { o[j] = fexp2(g0[j] * -LOG2E); o[4 + j] = fexp2(g1[j] * -LOG2E); }
#pragma unroll
                for (int j = 0; j < 8; ++j) o[j] = frcp(1.f + o[j]);
#pragma unroll
                for (int j = 0; j < 4; ++j) { o[j] = (g0[j] * u0[j]) * o[j]; o[4 + j] = (g1[j] * u1[j]) * o[4 + j]; }
                u32x2 w; w.x = pk4_fp8(o[0], o[1], o[2], o[3]); w.y = pk4_fp8(o[4], o[5], o[6], o[7]);
                if (rl < u.nvalid) *(u32x2*)(act + (size_t)(u.orow + rl) * ldc + col) = w;
            }
    }
};

struct EpiResid {
    static constexpr bool PERM = true; static constexpr unsigned SCALE_B = 0x7F7F7F7Fu;
    const float* xin32; const bf16* xin16; bf16* xout; const float* gate;
    __device__ __forceinline__ void operator()(const f32x4 (&acc)[2][2][4][2], const Unit& u, int wr, int wc, int fr, int fq) const {
        const int b = u.orow / SEQ; const float* gv = gate + (size_t)b * 6144;
#pragma unroll
        for (int bj = 0; bj < 2; ++bj) {
            const int col = u.pn * 256 + bj * 128 + wc * 32 + 8 * fq;
            const f32x4 g0 = *(const f32x4*)(gv + col), g1 = *(const f32x4*)(gv + col + 4);
#pragma unroll
            for (int ai = 0; ai < 2; ++ai)
#pragma unroll
                for (int m = 0; m < 4; ++m) {
                    const size_t off = (size_t)(u.orow + ai * 128 + wr * 64 + m * 16 + fr) * DM + col;
                    f32x4 x0, x1;
                    if (xin32) { x0 = *(const f32x4*)(xin32 + off); x1 = *(const f32x4*)(xin32 + off + 4); }
                    else { const u32x4 y = *(const u32x4*)(xin16 + off);
                        x0 = (f32x4){__uint_as_float(y.x << 16), __uint_as_float(y.x & 0xFFFF0000u), __uint_as_float(y.y << 16), __uint_as_float(y.y & 0xFFFF0000u)};
                        x1 = (f32x4){__uint_as_float(y.z << 16), __uint_as_float(y.z & 0xFFFF0000u), __uint_as_float(y.w << 16), __uint_as_float(y.w & 0xFFFF0000u)}; }
                    const f32x4 o0 = x0 + g0 * acc[ai][bj][m][0], o1 = x1 + g1 * acc[ai][bj][m][1];
                    u32x4 w; w.x = cvt_pk_bf16(o0[0], o0[1]); w.y = cvt_pk_bf16(o0[2], o0[3]); w.z = cvt_pk_bf16(o1[0], o1[1]); w.w = cvt_pk_bf16(o1[2], o1[3]);
                    *(u32x4*)(xout + off) = w;
                    if (m == 3) asm volatile("" ::: "memory");
                }
        }
    }
};

template <int NB> struct EpiMoeDownT {
    static constexpr bool PERM = true; static constexpr unsigned SCALE_B = 0x79797979u;
    bf16* x; bf16* y1; const float* gate; const int* perm; const float* tw;
    __device__ __forceinline__ void operator()(const f32x4 (&acc)[2][2][4][2], const Unit& u, int wr, int wc, int fr, int fq) const {
        const int* pl = perm + u.aux;
        int tok[8]; unsigned s1m[8]; float wgt[8];
#pragma unroll
        for (int i = 0; i < 8; ++i) { const int rl = (i >> 2) * 128 + wr * 64 + (i & 3) * 16 + fr; const int ent = pl[rl < u.nvalid ? rl : u.nvalid - 1]; tok[i] = ent & 0xFFFF; s1m[i] = (unsigned)(ent >> 16); }
#pragma unroll
        for (int i = 0; i < 8; ++i) wgt[i] = tw[tok[i] * 2 + (int)s1m[i]];
        asm volatile("" ::: "memory");
#pragma unroll
        for (int bj = 0; bj < NB; ++bj) {
            const int col = (NB == 2 ? u.pn * 256 + bj * 128 : u.pn * 128) + wc * 32 + 8 * fq;
#pragma unroll
            for (int hf = 0; hf < 2; ++hf) {
                f32x4 ga[4], gb[4]; u32x4 y[4]; bf16* p[4];
#pragma unroll
                for (int m = 0; m < 4; ++m) { const int i = hf * 4 + m; const float* gv = gate + (size_t)(tok[i] / SEQ) * 6144 + col;
                    p[m] = (s1m[i] ? y1 : x) + (size_t)tok[i] * DM + col; ga[m] = *(const f32x4*)gv; gb[m] = *(const f32x4*)(gv + 4); y[m] = *(const u32x4*)p[m]; }
#pragma unroll
                for (int m = 0; m < 4; ++m) { const int i = hf * 4 + m; const int rl = hf * 128 + wr * 64 + m * 16 + fr;
                    const f32x4 v0 = ga[m] * acc[hf][bj][m][0] * wgt[i], v1 = gb[m] * acc[hf][bj][m][1] * wgt[i];
                    const unsigned km = s1m[i] ? 0u : 0xFFFFFFFFu;
                    const u32x4 yy = (u32x4){y[m].x & km, y[m].y & km, y[m].z & km, y[m].w & km};
                    const f32x4 o0 = (f32x4){__uint_as_float(yy.x << 16), __uint_as_float(yy.x & 0xFFFF0000u), __uint_as_float(yy.y << 16), __uint_as_float(yy.y & 0xFFFF0000u)} + v0;
                    const f32x4 o1 = (f32x4){__uint_as_float(yy.z << 16), __uint_as_float(yy.z & 0xFFFF0000u), __uint_as_float(yy.w << 16), __uint_as_float(yy.w & 0xFFFF0000u)} + v1;
                    u32x4 w; w.x = cvt_pk_bf16(o0[0], o0[1]); w.y = cvt_pk_bf16(o0[2], o0[3]); w.z = cvt_pk_bf16(o1[0], o1[1]); w.w = cvt_pk_bf16(o1[2], o1[3]);
                    if (rl < u.nvalid) *(u32x4*)p[m] = w; }
                asm volatile("" ::: "memory");
            }
        }
    }
};
typedef EpiMoeDownT<2> EpiMoeDown;

struct MoeOrder {
    const volatile LAS int* tab; int G, c, NPN, kind, lim;
    __device__ bool next(int i, Unit& u) const {
#define TABU(k) __builtin_amdgcn_readfirstlane(tab[k])
        int L = i * G + c; const int total = TABU(32); int half = 0;
        if (kind == 2) { if (L >= 2 * (total - lim)) return false; half = L & 1; L = lim + (L >> 1); }
        else if (L >= (total < lim ? total : lim)) return false;
        int e = 0;
#pragma unroll
        for (int k = 1; k < 8; ++k) e += (L >= TABU(24 + k)) ? 1 : 0;
        const int pfx = TABU(24 + e), ntm = TABU(16 + e), cnt = TABU(e), base = TABU(8 + e);
        int rem = L - pfx - ((ntm * NPN >= 32) ? ((32 - (pfx & 31)) & 31) : 0); rem += (rem < 0) ? ntm * NPN : 0;
        int pn, mt;
        { const int full = (ntm >> 3) * 8 * NPN, ng = NPN >> 2;
          if (rem < full) { const int blk = rem >> 5, w = rem & 31, pbk = blk / ng, gq = blk - pbk * ng; mt = pbk * 8 + (w & 7); pn = gq * 4 + (w >> 3); }
          else { const int r8 = ntm & 7, rem2 = rem - full; pn = rem2 / r8; mt = (ntm & ~7) + (rem2 - pn * r8); }
          pn = __builtin_amdgcn_readfirstlane(pn); mt = __builtin_amdgcn_readfirstlane(mt); }
#undef TABU
        const int nv = cnt - mt * 256;
#define RFL(x) __builtin_amdgcn_readfirstlane(x)
        u.nvalid = RFL(nv < 256 ? nv : 256); u.pn = RFL(pn); u.acolb = 0;
        u.aux = RFL(e * T + mt * 256);
        if (kind == 0) { u.arow = RFL(e * T + mt * 256); u.brow = RFL(e * (2 * FFE) + pn * 256); u.orow = RFL(base + mt * 256); }
        else if (kind == 1) { u.arow = RFL(base + mt * 256);  u.brow = RFL(e * DM + pn * 256);        u.orow = 0; }
        else           { u.arow = RFL(base + mt * 256);  u.brow = RFL(e * DM + pn * 256 + half * 128); u.pn = RFL(pn * 2 + half); u.orow = 0; }
#undef RFL
        return true;
    }
};
__device__ __forceinline__ void moe_tables(volatile LAS int* tab, const unsigned* cntw, int npn, int wid) {
    if (wid == 0) {
        const int ln = lane_id();
        int c = 0;
        if (ln < 8) c = (int)__hip_atomic_load(cntw + 64 * ln, RLX_AGENT);
        const int ntm = (c + 255) >> 8, nu = ntm * npn;
        int b = c, up = nu;
#pragma unroll
        for (int o = 1; o < 8; o <<= 1) {
            const int tb = __builtin_amdgcn_ds_bpermute(((ln - o) & 63) << 2, b), tu = __builtin_amdgcn_ds_bpermute(((ln - o) & 63) << 2, up);
            if (ln >= o) { b += tb; up += tu; }
        }
        if (ln < 8) { tab[ln] = c; tab[8 + ln] = b - c; tab[16 + ln] = ntm; tab[24 + ln] = up - nu; }
        if (ln == 7) tab[32] = up;
    }
    __syncthreads();
}
struct UpOrder {
    int G, c, pm0, npm;
    __device__ bool next(int i, Unit& u) const {
        const int L = i * G + c; if (L >= npm * 6) return false;
        const int pn = __builtin_amdgcn_readfirstlane(L / npm), pm = __builtin_amdgcn_readfirstlane(pm0 + (L - (L / npm) * npm));
        u.arow = pm * 256; u.acolb = (pn >= 3) ? 512 : 0; u.brow = pn * 256; u.orow = pm * 256; u.pn = pn; u.nvalid = 256; u.aux = 0; return true;
    }
};

struct OneUnit { Unit u; __device__ bool next(int i, Unit& o) const { if (i != 0) return false; o = u; return true; } };

namespace att {
constexpr int KSLOT = 12288, VSLOT = 8192, FBSLOT = 256, SLOT = KSLOT + VSLOT + FBSLOT;
constexpr int L_WSF = 4 * SLOT;
constexpr int L_TB = L_WSF + 8 * 256;
constexpr int L_OST = L_TB + 512;
constexpr int L_END = L_OST + 8 * 4096;
static_assert(L_END <= RING_BYTES, "attention LDS");
__device__ __forceinline__ int crow(int r, int hi) { return (r & 3) + 8 * (r >> 2) + 4 * hi; }
__device__ __forceinline__ s16x4 vtr(const LAS unsigned char* p) {
    typedef short v4i16_t __attribute__((ext_vector_type(4)));
    return __builtin_bit_cast(s16x4, __builtin_amdgcn_ds_read_tr16_b64_v4i16((LAS v4i16_t*)p));
}
__device__ __forceinline__ float xhalf_max(float m) { auto rr = __builtin_amdgcn_permlane32_swap(__float_as_uint(m), __float_as_uint(m), false, false); return fmaxf(__uint_as_float(rr[0]), __uint_as_float(rr[1])); }
__device__ __forceinline__ float xhalf_sum(float m) { auto rr = __builtin_amdgcn_permlane32_swap(__float_as_uint(m), __float_as_uint(m), false, false); return __uint_as_float(rr[0]) + __uint_as_float(rr[1]); }

struct Tensors { const bf16* Q; const bf16* K; const bf16* V; int qp, kp, vp, qw, kw; bf16* O; int ocol; const float* FB; const float* relb; const float* dlam; const float* subg; float lam_init; };

template <int TYPE>
__device__ __forceinline__ void attn_unit(const Tensors& P, int b, int h, int qb, LAS unsigned char* shm_in, int wid_in) {
    LAS unsigned char* shm = shm_in; int wid = wid_in; asm volatile("" : "+s"(shm), "+s"(wid));
    constexpr int NPASS = (TYPE == 0) ? 2 : 1, DQK = (TYPE == 0) ? 32 : (TYPE == 1 ? 80 : 96), NKC = DQK / 8, ND = DQK / 16, NG = 2 * ND;
    int lane_ = lane_id(); asm volatile("" : "+v"(lane_));
    const int lane = lane_, tid = wid * 64 + lane, r32 = lane & 31, hi = lane >> 5;
    const int nk = (NKC - wid + 7) / 8;
    const long rowbase = (long)b * SEQ; const int q0 = qb * 256;
    const bf16* Kh = P.K + rowbase * P.kp + h * P.kw;
    const bf16* Vh = P.V + rowbase * P.vp + h * 64;
    const unsigned shmb = (unsigned)(uintptr_t)shm;
    LAS float* wsf = (LAS float*)(shm + L_WSF) + wid * 64;
    LAS float* TBs = (LAS float*)(shm + L_TB);
    const int NT = 4 * (qb + 1);
    const int qrow = q0 + wid * 32 + r32;
    const unsigned kvoff = (unsigned)(lane * P.kp * 2), vvoff = (unsigned)(((lane >> 2) * P.vp + (lane & 3) * 8) * 2);
#define ATT_DMA(tk, sk, tv, sv) do { \
        for (int p_ = wid; p_ < NKC; p_ += 8) glds16(Kh + kpass + (long)(64 * (tk)) * P.kp + p_ * 8, kvoff, shmb + (unsigned)(sk) * SLOT + p_ * 1024); \
        glds16(Vh + (long)(64 * (tv) + 16 * (wid & 3)) * P.vp + (wid >> 2) * 32, vvoff, shmb + (unsigned)(sv) * SLOT + KSLOT + wid * 1024); } while (0)
#define ATT_BAR() asm volatile("s_waitcnt lgkmcnt(0)\n\ts_barrier" ::: "memory")
#define ATT_WB0() asm volatile("s_waitcnt vmcnt(0) lgkmcnt(0)\n\ts_barrier" ::: "memory")
#define ATT_WB2() do { if (nk == 0) asm volatile("s_waitcnt vmcnt(2) lgkmcnt(0)\n\ts_barrier" ::: "memory"); else if (nk == 1) asm volatile("s_waitcnt vmcnt(4) lgkmcnt(0)\n\ts_barrier" ::: "memory"); \
        else asm volatile("s_waitcnt vmcnt(6) lgkmcnt(0)\n\ts_barrier" ::: "memory"); } while (0)
#define ATT_SB() __builtin_amdgcn_sched_barrier(0)
#define ATT_PIN(x) asm volatile("" : "+v"(x))
#define ATT_MF(a_, b_, c_) __builtin_amdgcn_mfma_f32_32x32x16_bf16(a_, b_, c_, 0, 0, 0)
    const LAS unsigned char* vp0 = shm + KSLOT + ((lane >> 4) & 1) * 32 + (lane & 3) * 8 + (4 * hi + ((lane & 15) >> 2)) * 64;
    const LAS unsigned char* kp0 = shm + hi * 1024 + r32 * 16;
    f32x16 o[2]; float l_reg = 0.f;
#pragma unroll 1
    for (int pass = 0; pass < NPASS; ++pass) {
    const int kpass = pass * 32;
    ATT_DMA(0, 0, 0, 0); ATT_DMA(1, 1, 1, 1); ATT_DMA(2, 2, 2, 2); ATT_DMA(3, 3, 3, 3);
    bf16x8 qf[ND];
    {
        const bf16* Qp = P.Q + (rowbase + qrow) * P.qp + h * P.qw;
#pragma unroll
        for (int d0 = 0; d0 < ND; ++d0) { if (TYPE == 1 && d0 == ND - 1) qf[d0] = (hi == 0) ? (bf16x8){0x3F80, 0x3F80, 0x3F80, 0, 0, 0, 0, 0} : (bf16x8){0, 0, 0, 0, 0, 0, 0, 0};
                                          else qf[d0] = *(const bf16x8*)(Qp + kpass + d0 * 16 + hi * 8); }
        if (TYPE == 0 && pass == 0) {
            if (tid < 128) {
                const int n = tid; int bk;
                if (n < 16) bk = n; else { bk = 16; const int th[15] = {19, 21, 24, 27, 31, 35, 40, 46, 52, 59, 67, 77, 87, 99, 113};
#pragma unroll
                    for (int k = 0; k < 15; ++k) bk += (n >= th[k]) ? 1 : 0; }
                TBs[n] = (P.relb[bk * 4 + h] - P.relb[31 * 4 + h]) * LOG2E;
            }
        }
#pragma unroll
        for (int d0 = 0; d0 < ND; ++d0) ATT_PIN(qf[d0]);
    }
    asm volatile("s_waitcnt vmcnt(0)" ::: "memory");
    float mhat = 0.f; l_reg = 0.f; o[0] = zero16_asm(); o[1] = zero16_asm();
    f32x16 negm = zero16_asm();
    f32x16 pA0, pA1, pB0, pB1; bf16x8 kf[NG]; bf16x8 vv[4]; u32x4 pw[4]; bool resc = false;
    ATT_BAR();
#define ATT_KLD(slot, d0) do { const LAS unsigned char* kb_ = kp0 + (slot) * SLOT + (d0) * 2048; kf[2 * (d0)] = *(const LAS bf16x8*)kb_; kf[2 * (d0) + 1] = *(const LAS bf16x8*)(kb_ + 512); } while (0)
#define ATT_VRD(dst, vp_, i) do { const s16x4 lo_ = vtr((vp_) + (((i) >> 2) * 4096 + ((i) & 3) * 1024)), hh_ = vtr((vp_) + (((i) >> 2) * 4096 + ((i) & 3) * 1024 + 512)); \
        dst = (bf16x8){lo_[0], lo_[1], lo_[2], lo_[3], hh_[0], hh_[1], hh_[2], hh_[3]}; } while (0)
#define ATT_NEAR(C0, C1, t) do { \
        int qr_ = qrow; asm volatile("" : "+v"(qr_)); \
        if (TYPE == 0) { _Pragma("unroll") for (int r = 0; r < 16; ++r) { int d0_ = qr_ - (64 * (t) + crow(r, hi)), d1_ = d0_ - 32; \
            d0_ = d0_ < 0 ? 0 : (d0_ > 127 ? 127 : d0_); d1_ = d1_ < 0 ? 0 : (d1_ > 127 ? 127 : d1_); C0[r] += TBs[d0_]; C1[r] += TBs[d1_]; } } \
        if ((t) >= NT - 4) { _Pragma("unroll") for (int r = 0; r < 16; ++r) { const int kv = 64 * (t) + crow(r, hi); if (kv > qr_) C0[r] = -INFINITY; if (kv + 32 > qr_) C1[r] = -INFINITY; } } } while (0)
#define ATT_RMAX(C0, C1, rm) do { float a_ = __builtin_fmaxf(__builtin_fmaxf(C0[0], C0[1]), C1[0]), b_ = __builtin_fmaxf(__builtin_fmaxf(C0[2], C0[3]), C1[1]); a_ = __builtin_fmaxf(__builtin_fmaxf(a_, C1[2]), C1[3]); \
        _Pragma("unroll") for (int r = 4; r < 16; r += 4) { a_ = __builtin_fmaxf(__builtin_fmaxf(a_, C0[r]), C0[r + 1]); b_ = __builtin_fmaxf(__builtin_fmaxf(b_, C0[r + 2]), C0[r + 3]); \
            a_ = __builtin_fmaxf(__builtin_fmaxf(a_, C1[r]), C1[r + 1]); b_ = __builtin_fmaxf(__builtin_fmaxf(b_, C1[r + 2]), C1[r + 3]); } \
        rm = xhalf_max(__builtin_fmaxf(a_, b_)); } while (0)
#pragma unroll
    for (int d0 = 0; d0 < ND; ++d0) ATT_KLD(0, d0);
#pragma unroll
    for (int d0 = 0; d0 < ND; ++d0) { pA0 = ATT_MF(kf[2 * d0], qf[d0], d0 == 0 ? negm : pA0); pA1 = ATT_MF(kf[2 * d0 + 1], qf[d0], d0 == 0 ? negm : pA1); }
    if (NT == 4) ATT_NEAR(pA0, pA1, 0);
    { float rm; ATT_RMAX(pA0, pA1, rm); mhat = rm;
#pragma unroll
      for (int r = 0; r < 16; ++r) negm[r] = -mhat;
#pragma unroll
      for (int r = 0; r < 16; ++r) { pA0[r] = fexp2(pA0[r] - rm); pA1[r] = fexp2(pA1[r] - rm); } }
    ATT_BAR();
    ATT_DMA((4 < NT ? 4 : NT - 1), 0, 2, 2);
#pragma unroll
    for (int d0 = 0; d0 < ND; ++d0) ATT_KLD(1, d0);
    ATT_WB2();
#define ATT_FILL(P0, P1, g) do { const int e_ = 4 * ((g) & 3); \
        if ((g) < 4) { sacc += P0[e_]; sacc += P0[e_ + 1]; sacc += P0[e_ + 2]; sacc += P0[e_ + 3]; pw[(g) >> 1][2 * ((g) & 1)] = cvt_pk_bf16(P0[e_], P0[e_ + 1]); pw[(g) >> 1][2 * ((g) & 1) + 1] = cvt_pk_bf16(P0[e_ + 2], P0[e_ + 3]); } \
        else { sacc += P1[e_]; sacc += P1[e_ + 1]; sacc += P1[e_ + 2]; sacc += P1[e_ + 3]; pw[(g) >> 1][2 * ((g) & 1)] = cvt_pk_bf16(P1[e_], P1[e_ + 1]); pw[(g) >> 1][2 * ((g) & 1) + 1] = cvt_pk_bf16(P1[e_ + 2], P1[e_ + 3]); } \
        ATT_PIN(pw[(g) >> 1]); ATT_PIN(sacc); } while (0)
#define ATT_STEP(C0, C1, P0, P1, t) do { ATT_SB(); \
        float sacc = 0.f; \
        _Pragma("unroll") for (int g = 0; g < NG; ++g) { \
            if ((g & 1) == 0) C0 = ATT_MF(kf[g], qf[g >> 1], g < 2 ? negm : C0); else C1 = ATT_MF(kf[g], qf[g >> 1], g < 2 ? negm : C1); \
            if (NG >= 8) { if (g < 8) ATT_FILL(P0, P1, g); } else { ATT_FILL(P0, P1, 2 * g); ATT_FILL(P0, P1, 2 * g + 1); } \
            ATT_SB(); } \
        const LAS unsigned char* vp_ = vp0 + (((t) - 1) & 3) * SLOT; \
        ATT_VRD(vv[0], vp_, 0); ATT_VRD(vv[1], vp_, 4); ATT_SB(); \
        l_reg += sacc; \
        { const int tk_ = (t) + 4 < NT ? (t) + 4 : NT - 1, tv_ = (t) + 2 < NT ? (t) + 2 : NT - 1; ATT_DMA(tk_, (t) & 3, tv_, ((t) + 2) & 3); } \
        if ((t) >= NT - 6) ATT_NEAR(C0, C1, t); \
        { float rm; ATT_RMAX(C0, C1, rm); resc = false; \
          if (__builtin_expect(__any(rm > 32.f), 0)) { const float dl = __builtin_fmaxf(rm, 0.f); mhat += dl;            \
              _Pragma("unroll") for (int r = 0; r < 16; ++r) negm[r] = -mhat; \
              _Pragma("unroll") for (int r = 0; r < 16; ++r) { C0[r] -= dl; C1[r] -= dl; } \
              const float f = fexp2(-dl); l_reg *= f; if (hi == 0) wsf[r32] = f; resc = true; } } \
        ATT_SB(); \
        _Pragma("unroll") for (int j = 0; j < 8; ++j) { \
            if (j + 2 < 8) { const int i_ = ((j + 2) >> 1) + 4 * ((j + 2) & 1); ATT_VRD(vv[(j + 2) & 3], vp_, i_); } \
            if (j >= 1 && j <= ND) ATT_KLD(((t) + 1) & 3, j - 1); \
            ATT_SB(); \
            o[j & 1] = ATT_MF(__builtin_bit_cast(bf16x8, pw[j >> 1]), vv[j & 3], o[j & 1]); \
            if (j < 4) { C0[4 * j] = fexp2(C0[4 * j]); C0[4 * j + 1] = fexp2(C0[4 * j + 1]); C0[4 * j + 2] = fexp2(C0[4 * j + 2]); C0[4 * j + 3] = fexp2(C0[4 * j + 3]); ATT_PIN(C0); } \
            else { C1[4 * j - 16] = fexp2(C1[4 * j - 16]); C1[4 * j - 15] = fexp2(C1[4 * j - 15]); C1[4 * j - 14] = fexp2(C1[4 * j - 14]); C1[4 * j - 13] = fexp2(C1[4 * j - 13]); ATT_PIN(C1); } \
            ATT_SB(); } \
    } while (0)
#define ATT_RESC() do { if (resc) { _Pragma("unroll") for (int r = 0; r < 16; ++r) { const float f_ = wsf[crow(r, hi)]; o[0][r] *= f_; o[1][r] *= f_; } } } while (0)
    {
        int t = 1;
#pragma unroll 1
        for (; t + 1 < NT; t += 2) {
            ATT_STEP(pB0, pB1, pA0, pA1, t);     ATT_WB2(); ATT_RESC();
            ATT_STEP(pA0, pA1, pB0, pB1, t + 1); ATT_WB2(); ATT_RESC();
        }
        ATT_STEP(pB0, pB1, pA0, pA1, NT - 1); ATT_WB0(); ATT_RESC();
    }
    { float sacc = 0.f;
#pragma unroll
      for (int r = 0; r < 16; ++r) sacc += pB0[r];
#pragma unroll
      for (int r = 0; r < 16; ++r) sacc += pB1[r];
      l_reg += sacc;
#pragma unroll
      for (int k = 0; k < 2; ++k) {
          pw[k] = (u32x4){cvt_pk_bf16(pB0[8 * k + 0], pB0[8 * k + 1]), cvt_pk_bf16(pB0[8 * k + 2], pB0[8 * k + 3]), cvt_pk_bf16(pB0[8 * k + 4], pB0[8 * k + 5]), cvt_pk_bf16(pB0[8 * k + 6], pB0[8 * k + 7])};
          pw[2 + k] = (u32x4){cvt_pk_bf16(pB1[8 * k + 0], pB1[8 * k + 1]), cvt_pk_bf16(pB1[8 * k + 2], pB1[8 * k + 3]), cvt_pk_bf16(pB1[8 * k + 4], pB1[8 * k + 5]), cvt_pk_bf16(pB1[8 * k + 6], pB1[8 * k + 7])}; }
      const LAS unsigned char* vp_ = vp0 + 3 * SLOT;
#pragma unroll
      for (int j = 0; j < 8; ++j) { const int i_ = (j >> 1) + 4 * (j & 1); bf16x8 vf_; ATT_VRD(vf_, vp_, i_); o[j & 1] = ATT_MF(__builtin_bit_cast(bf16x8, pw[j >> 1]), vf_, o[j & 1]); } }
    ATT_BAR();
    if (TYPE == 0 && pass == 0) {
        const float rl0 = frcp(xhalf_sum(l_reg)); if (hi == 0) wsf[r32] = rl0;
        LDS_WAIT();
        LAS bf16* stg0 = (LAS bf16*)(shm + L_OST) + wid * 2048;
#pragma unroll
        for (int r = 0; r < 16; ++r) { const int orow = crow(r, hi); const float f = wsf[orow];
            const unsigned w = cvt_pk_bf16(o[0][r] * f, o[1][r] * f); stg0[orow * 64 + r32] = (bf16)(w & 0xFFFFu); stg0[orow * 64 + 32 + r32] = (bf16)(w >> 16); }
        LDS_WAIT();
    }
    }
    {
    int le_ = lane_id(); asm volatile("" : "+v"(le_));
    const int r32e = le_ & 31, hie = le_ >> 5;
    { const float rl = frcp(xhalf_sum(l_reg)); if (hie == 0) wsf[r32e] = rl; }
    LDS_WAIT();
    LAS bf16* stg = (LAS bf16*)(shm + L_OST) + wid * 2048;
    float gd[2] = {0.f, 0.f}, lam = 0.f;
    if (TYPE == 0) {
        float s1 = 0.f, s2 = 0.f;
        if (le_ < 32) { s1 = P.dlam[le_] * P.dlam[32 + le_]; s2 = P.dlam[64 + le_] * P.dlam[96 + le_]; }
        s1 = wave_sum(s1); s2 = wave_sum(s2);
        unsigned liu_ = __builtin_amdgcn_readfirstlane(__float_as_uint(P.lam_init)); asm volatile("" : "+s"(liu_)); const float lam_init = __uint_as_float(liu_);
        lam = __expf(s1) - __expf(s2) + lam_init;
        gd[0] = P.subg[r32e] * (1.f - lam_init); gd[1] = P.subg[32 + r32e] * (1.f - lam_init);
    }
#pragma unroll
    for (int r = 0; r < 16; ++r) {
        const int orow = crow(r, hie);
        float v0, v1;
        if (TYPE == 0) {
            const float rb = wsf[orow] * lam;
            v0 = bf2f(stg[orow * 64 + r32e]) - o[0][r] * rb; v1 = bf2f(stg[orow * 64 + 32 + r32e]) - o[1][r] * rb;
            float ss = v0 * v0 + v1 * v1;
            ss = sum32_dpp(ss);
            const float rn = rsqrtf(ss * (1.f / 64.f) + EPS);
            v0 *= rn * gd[0]; v1 *= rn * gd[1];
        } else {
            const float ra = wsf[orow]; v0 = o[0][r] * ra; v1 = o[1][r] * ra;
        }
        stg[orow * 64 + r32e] = (bf16)(cvt_pk_bf16(v0, v0) & 0xFFFFu);
        stg[orow * 64 + 32 + r32e] = (bf16)(cvt_pk_bf16(v1, v1) & 0xFFFFu);
    }
    LDS_WAIT();
    bf16* Ow = P.O + (rowbase + q0 + wid * 32) * DM + P.ocol + h * 64;
#pragma unroll
    for (int i = 0; i < 4; ++i) { const int row = i * 8 + (le_ >> 3), ch = le_ & 7; const u32x4 v = *(const LAS u32x4*)(stg + row * 64 + ch * 8); *(u32x4*)(Ow + (long)row * DM + ch * 8) = v; }
    }
    ATT_BAR();
#undef ATT_DMA
#undef ATT_BAR
#undef ATT_WB0
#undef ATT_WB2
#undef ATT_SB
#undef ATT_PIN
#undef ATT_MF
#undef ATT_KLD
#undef ATT_VRD
#undef ATT_NEAR
#undef ATT_RMAX
#undef ATT_FILL
#undef ATT_STEP
#undef ATT_RESC
}
__device__ __forceinline__ void decode_unit(int u, int& type, int& qb, int& b, int& h) {
    const int order[24] = {0 * 8 + 7, 0 * 8 + 6, 0 * 8 + 5, 0 * 8 + 4, 2 * 8 + 7, 1 * 8 + 7, 2 * 8 + 6, 0 * 8 + 3, 1 * 8 + 6, 2 * 8 + 5, 1 * 8 + 5, 0 * 8 + 2,
                           2 * 8 + 4, 1 * 8 + 4, 0 * 8 + 1, 2 * 8 + 3, 1 * 8 + 3, 2 * 8 + 2, 1 * 8 + 2, 0 * 8 + 0, 2 * 8 + 1, 1 * 8 + 1, 2 * 8 + 0, 1 * 8 + 0};
    int rem = u; type = 0; qb = 0;
#pragma unroll
    for (int k = 0; k < 24; ++k) { const int ty = order[k] >> 3; const int n = (ty == 0) ? 32 : 48; if (rem >= 0 && rem < n) { type = ty; qb = order[k] & 7; const int nh = (ty == 0) ? 4 : 6; b = rem / nh; h = rem - b * nh; } rem -= n; }
}
__device__ __forceinline__ void decode_unit_local(int u, int& type, int& qb, int& h) {
    const int order[24] = {0 * 8 + 7, 0 * 8 + 6, 0 * 8 + 5, 0 * 8 + 4, 2 * 8 + 7, 1 * 8 + 7, 2 * 8 + 6, 0 * 8 + 3, 1 * 8 + 6, 2 * 8 + 5, 1 * 8 + 5, 0 * 8 + 2,
                           2 * 8 + 4, 1 * 8 + 4, 0 * 8 + 1, 2 * 8 + 3, 1 * 8 + 3, 2 * 8 + 2, 1 * 8 + 2, 0 * 8 + 0, 2 * 8 + 1, 1 * 8 + 1, 2 * 8 + 0, 1 * 8 + 0};
    int rem = u; type = 0; qb = 0; h = 0;
#pragma unroll
    for (int k = 0; k < 24; ++k) { const int ty = order[k] >> 3; const int n = (ty == 0) ? 4 : 6; if (rem >= 0 && rem < n) { type = ty; qb = order[k] & 7; h = rem; } rem -= n; }
}
}

struct Args { const float* in[24]; float* out; unsigned char* ws; int ph_lo, ph_hi; };
typedef const __attribute__((address_space(4))) Args* ArgP;
__device__ __forceinline__ ArgP argp() { ArgP p = (ArgP)__builtin_amdgcn_kernarg_segment_ptr(); asm volatile("" : "+s"(p)); return p; }
enum { I_X = 0, I_C, I_WADA, I_BADA, I_ANORM, I_FNORM, I_WIN, I_BFORGET, I_DLAM, I_SUBLN, I_RELB, I_QNORM, I_KVNORM, I_WUQ, I_WUKV, I_WOUT,
       I_FGATE, I_FUP, I_FDOWN, I_ROUTER, I_MGATE, I_MUP, I_MDOWN, I_FINAL };

__device__ __forceinline__ int dstrow(int kind, int n) {
    if (kind == 0) return n;
    if (kind == 1) { if (n < 1920) return n; if (n < 1926) return 2336 + (n - 1920); if (n < 2182) return 1920 + (n - 1926); if (n < 2310) return 2176 + (n - 2182); return 2304 + (n - 2310); }
    if (kind == 2) return 256 * (n >> 7) + (n & 127);
    if (kind == 3) return 256 * (n >> 7) + 128 + (n & 127);
    if (kind == 4) { const int h = n / 96, d = n - h * 96; if (d < 64) return h * 64 + d; const int rd = d - 64, n2 = rd >> 4, i = rd & 15; return 384 + h * 32 + 8 * (i >> 2) + 4 * n2 + (i & 3); }
    { const int h = n >> 7, d = n & 127; return d < 64 ? 768 + h * 64 + d : 1152 + h * 64 + (d - 64); }
}
__device__ __forceinline__ void transpose_item(const float* W, int N, bf16* WT, int ldd, int kind, const float* kscale, LAS float* scr, int item, int lane) {
    const int nblk = (N + 31) >> 5, kb = item / nblk, nb = item - kb * nblk, k0 = 64 * kb, n0 = 32 * nb;
    const int nn = n0 + (lane & 31); const bool inb = nn < N;
    float tv[32];
#pragma unroll
    for (int i = 0; i < 32; ++i) { const int kk = 2 * i + (lane >> 5); tv[i] = inb ? W[(size_t)(k0 + kk) * N + nn] : 0.f; }
#pragma unroll
    for (int i = 0; i < 32; ++i) { const int kk = 2 * i + (lane >> 5); float v = tv[i]; if (kscale) v *= kscale[k0 + kk]; scr[kk * 33 + (lane & 31)] = v; }
    LDS_WAIT(); asm volatile("" ::: "memory");
    const int c = lane & 7;
#pragma unroll
    for (int j = 0; j < 4; ++j) { const int nl = (lane >> 3) + 8 * j; const int n = n0 + nl; const LAS float* s = scr + (8 * c) * 33 + nl;
        if (n < N) { const int dr = dstrow(kind, n);
            u32x4 o; o.x = cvt_pk_bf16(s[0 * 33], s[1 * 33]); o.y = cvt_pk_bf16(s[2 * 33], s[3 * 33]); o.z = cvt_pk_bf16(s[4 * 33], s[5 * 33]); o.w = cvt_pk_bf16(s[6 * 33], s[7 * 33]);
            *(u32x4*)(WT + (size_t)dr * ldd + k0 + 8 * c) = o; } }
    LDS_WAIT(); asm volatile("" ::: "memory");
}
__device__ __forceinline__ void transpose_item8(const float* W, int N, fp8* WT, int ldd, int kind, LAS float* scr, int item, int lane) {
    const int nblk = (N + 31) >> 5, kb = item / nblk, nb = item - kb * nblk, k0 = 128 * kb, n0 = 32 * nb;
    const int nl = lane & 31, h = lane >> 5, nn = n0 + nl; const bool inb = nn < N;
    LAS unsigned* P = (LAS unsigned*)scr;
#pragma unroll
    for (int sub = 0; sub < 2; ++sub) {
        float tv[32];
#pragma unroll
        for (int i = 0; i < 32; ++i) tv[i] = inb ? W[(size_t)(k0 + 64 * sub + 32 * h + i) * N + nn] : 0.f;
#pragma unroll
        for (int d = 0; d < 8; ++d) P[nl * 33 + 16 * sub + 8 * h + d] = pk4_fp8(tv[4 * d] * 64.f, tv[4 * d + 1] * 64.f, tv[4 * d + 2] * 64.f, tv[4 * d + 3] * 64.f);
    }
    LDS_WAIT(); asm volatile("" ::: "memory");
    const int ch = lane & 7;
#pragma unroll
    for (int j = 0; j < 4; ++j) { const int nr = (lane >> 3) + 8 * j; const int n = n0 + nr; const LAS unsigned* p = P + nr * 33 + 4 * ch;
        if (n < N) { const int dr = dstrow(kind, n); u32x4 o; o.x = p[0]; o.y = p[1]; o.z = p[2]; o.w = p[3];
            *(u32x4*)(WT + (size_t)dr * ldd + k0 + 16 * ch) = o; } }
    LDS_WAIT(); asm volatile("" ::: "memory");
}
template <int ES>
__device__ __forceinline__ void transpose_tile(const float* W, int N, unsigned char* WT, int lddB, int kind, LAS unsigned char* lds, int tile, int wid, int lane) {
    constexpr int KT = 128 / ES, KW = KT / 8;
    const int ntn = (N + 511) >> 9, kb = tile / ntn, nb = tile - kb * ntn, k0 = kb * KT, n0 = nb * 512;
    f32x4 v[KW][2];
#pragma unroll
    for (int r = 0; r < KW; ++r)
#pragma unroll
        for (int c = 0; c < 2; ++c) { const int nn = n0 + 256 * c + 4 * lane; v[r][c] = (nn < N) ? *(const f32x4*)(W + (size_t)(k0 + wid * KW + r) * N + nn) : (f32x4){0.f, 0.f, 0.f, 0.f}; }
#pragma unroll
    for (int c = 0; c < 2; ++c)
#pragma unroll
        for (int j = 0; j < 4; ++j) {
            u32x4 o;
            if constexpr (ES == 1) {
                o.x = pk4_fp8(v[0][c][j] * 64.f, v[1][c][j] * 64.f, v[2][c][j] * 64.f, v[3][c][j] * 64.f); o.y = pk4_fp8(v[4][c][j] * 64.f, v[5][c][j] * 64.f, v[6][c][j] * 64.f, v[7][c][j] * 64.f);
                o.z = pk4_fp8(v[8][c][j] * 64.f, v[9][c][j] * 64.f, v[10][c][j] * 64.f, v[11][c][j] * 64.f); o.w = pk4_fp8(v[12][c][j] * 64.f, v[13][c][j] * 64.f, v[14][c][j] * 64.f, v[15][c][j] * 64.f);
            } else {
                o.x = cvt_pk_bf16(v[0][c][j], v[1][c][j]); o.y = cvt_pk_bf16(v[2][c][j], v[3][c][j]); o.z = cvt_pk_bf16(v[4][c][j], v[5][c][j]); o.w = cvt_pk_bf16(v[6][c][j], v[7][c][j]);
            }
            const int row = 256 * c + 4 * lane + j;
            *(LAS u32x4*)(lds + row * 128 + ((wid ^ ((row >> 2) & 7)) << 4)) = o;
        }
    __syncthreads();
#pragma unroll
    for (int i = 0; i < 8; ++i) {
        const int row = 64 * wid + 8 * i + (lane >> 3), ch = lane & 7, n = n0 + row;
        if (n < N) { const u32x4 o = *(const LAS u32x4*)(lds + row * 128 + ((ch ^ ((row >> 2) & 7)) << 4)); *(u32x4*)(WT + (size_t)dstrow(kind, n) * lddB + k0 * ES + 16 * ch) = o; }
    }
    __syncthreads();
}
__device__ __forceinline__ void prologue(ArgP a, LAS unsigned char* lds, int wid, int Gx, int Bx) {
    const int lane = lane_id(), tid = wid * 64 + lane;
    const int G = Gx, bx = Bx;
    unsigned char* ws = a->ws;
    {
        const int gw = bx * NWAVES + wid;
        if (gw % 5 == 0 && gw / 5 < 384) {
            const int it = gw / 5, l = it / 192, rem = it - l * 192, kc = rem / 24, cb = rem - kc * 24;
            LAS float* ctab = (LAS float*)(lds + wid * 16384);
#pragma unroll
            for (int q = 0; q < 16; ++q) { const int idx = q * 64 + lane, b = idx >> 7, jj = idx & 127; const float v = a->in[I_C][b * 1024 + kc * 128 + jj]; ctab[idx] = v * frcp(1.f + __expf(-v)); }
            LDS_WAIT(); asm volatile("" ::: "memory");
            f32x4 acc[8];
#pragma unroll
            for (int b = 0; b < 8; ++b) acc[b] = (f32x4){0.f, 0.f, 0.f, 0.f};
            const float* wp = a->in[I_WADA] + ((size_t)l * 1024 + kc * 128) * 6144 + cb * 256 + 4 * lane;
#pragma unroll 1
            for (int k0 = 0; k0 < 128; k0 += 16) {
                f32x4 w[16];
#pragma unroll
                for (int k = 0; k < 16; ++k) w[k] = *(const f32x4*)(wp + (size_t)(k0 + k) * 6144);
#pragma unroll
                for (int k = 0; k < 16; ++k) {
                    if ((k & 3) == 0) asm volatile("" : "+v"(acc[0]), "+v"(acc[1]), "+v"(acc[2]), "+v"(acc[3]), "+v"(acc[4]), "+v"(acc[5]), "+v"(acc[6]), "+v"(acc[7]) :: "memory");
#pragma unroll
                    for (int b = 0; b < 8; ++b) acc[b] += w[k] * ctab[b * 128 + k0 + k]; }
            }
            float* mp = (float*)(ws + WS_MODP) + ((size_t)(kc * 2 + l) * 8) * 6144 + cb * 256 + 4 * lane;
#pragma unroll
            for (int b = 0; b < 8; ++b) *(f32x4*)(mp + (size_t)b * 6144) = acc[b];
            LDS_WAIT(); asm volatile("" ::: "memory");
        }
    }
    {
        const double fr[16] = {1.0, 0.5623413251903491, 0.31622776601683794, 0.1778279410038923, 0.1, 0.05623413251903491, 0.03162277660168379, 0.01778279410038923,
                               0.01, 0.005623413251903491, 0.0031622776601683794, 0.0017782794100389228, 0.001, 0.0005623413251903491, 0.00031622776601683794, 0.00017782794100389227};
        const int gt = bx * NTHREADS + tid;
        if (gt < SEQ * 16) {
            const int pos = gt >> 4, i = gt & 15; double f = fr[0];
#pragma unroll
            for (int k = 1; k < 16; ++k) f = (i == k) ? fr[k] : f;
            const double rev = (double)pos * f * 0.15915494309189535; const double frac = rev - __builtin_floor(rev + 0.5);
            ((float*)(ws + WS_COS))[gt] = __builtin_amdgcn_cosf((float)frac); ((float*)(ws + WS_SIN))[gt] = __builtin_amdgcn_sinf((float)frac);
        }
    }
    {
        const int gt = bx * NTHREADS + tid, GT = G * NTHREADS; const u32x4 z = (u32x4){0u, 0u, 0u, 0u};
        for (int l = 0; l < 2; ++l) {
            bf16* win = (bf16*)(ws + WS_WIN) + (size_t)l * NIN * 1024;
            for (int i = gt; i < (NIN - INW) * 128; i += GT) *(u32x4*)(win + (size_t)INW * 1024 + (size_t)i * 8) = z;
            bf16* wup = (bf16*)(ws + WS_WUP) + (size_t)l * 1536 * 256;
            for (int i = gt; i < 192 * 32; i += GT) *(u32x4*)(wup + (size_t)576 * 256 + (size_t)i * 8) = z;
            for (int i = gt; i < 768 * 16; i += GT) { const int r = i >> 4, c = i & 15; *(u32x4*)(wup + (size_t)(768 + r) * 256 + 128 + c * 8) = z; }
        }
    }
    {
        LAS float* scr = (LAS float*)(lds + wid * 16384);
        const int gw = bx * NWAVES + wid, NGW = G * NWAVES;
        constexpr int I_IN = 16 * 74, I_UQ = 4 * 18, I_UKV = 2 * 24;
        constexpr int NITEMS = 2 * (I_IN + I_UQ + I_UKV);
        for (int it = gw; it < NITEMS; it += NGW) {
            int r = it;
            if (r < 2 * I_IN) { const int l = r / I_IN; r -= l * I_IN; transpose_item(a->in[I_WIN] + (size_t)l * 1024 * INW, INW, (bf16*)(ws + WS_WIN) + (size_t)l * NIN * 1024, 1024, 1, nullptr, scr, r, lane); continue; } r -= 2 * I_IN;
            if (r < 2 * I_UQ) { const int l = r / I_UQ; r -= l * I_UQ; transpose_item(a->in[I_WUQ] + (size_t)l * 256 * 576, 576, (bf16*)(ws + WS_WUP) + (size_t)l * 1536 * 256, 256, 4, a->in[I_QNORM] + l * 256, scr, r, lane); continue; } r -= 2 * I_UQ;
            { const int l = r / I_UKV; r -= l * I_UKV; transpose_item(a->in[I_WUKV] + (size_t)l * 128 * 768, 768, (bf16*)(ws + WS_WUP) + (size_t)l * 1536 * 256, 256, 5, a->in[I_KVNORM] + l * 128, scr, r, lane); }
        }
    }
    __syncthreads();
    {
        constexpr int T_OUT = 16 * 2, T_FG = 16 * 6, T_FD = 44 * 2;
        constexpr int NTILES = 2 * T_OUT + 2 * T_FG + T_FD;
        for (int it = G - 1 - bx; it < NTILES; it += G) {
            int r = it;
            if (r < 2 * T_OUT) { const int l = r / T_OUT; r -= l * T_OUT; transpose_tile<2>(a->in[I_WOUT] + (size_t)l * 1024 * 1024, 1024, ws + WS_WOUT + (size_t)l * 1024 * 1024 * 2, 2048, 0, lds, r, wid, lane); continue; } r -= 2 * T_OUT;
            if (r < T_FG) { transpose_tile<2>(a->in[I_FGATE], FFD, ws + WS_WGU, 2048, 2, lds, r, wid, lane); continue; } r -= T_FG;
            if (r < T_FG) { transpose_tile<2>(a->in[I_FUP], FFD, ws + WS_WGU, 2048, 3, lds, r, wid, lane); continue; } r -= T_FG;
            transpose_tile<2>(a->in[I_FDOWN], 1024, ws + WS_WDN, FFD * 2, 0, lds, r, wid, lane);
        }
    }
}
constexpr int CONV_TILES = 8 * (2 * 56 + 56);
__device__ __forceinline__ void moe_convert(ArgP a, LAS unsigned char* lds_in, int wid_in, int quota) {
    LAS unsigned char* lds = lds_in; int wid = wid_in; asm volatile("" : "+s"(lds), "+s"(wid));
    const int lane = lane_id();
    unsigned char* ws = a->ws;
    volatile LAS unsigned* mq = (volatile LAS unsigned*)(lds + MISC_OFF);
    for (int q = 0; q < quota; ++q) {
        if (wid == 0 && lane == 0) mq[6] = __hip_atomic_fetch_add((unsigned*)(ws + WS_CTL) + CW_CONVQ, 1u, RLX_AGENT);
        __syncthreads();
        const int idx = __builtin_amdgcn_readfirstlane((int)mq[6]);
        if (idx >= CONV_TILES) break;
        const int e = idx / 168; int r = idx - e * 168;
        if (r < 56) transpose_tile<1>(a->in[I_MGATE] + (size_t)e * 1024 * FFE, FFE, ws + WS_MGU + (size_t)e * 2 * FFE * 1024, 1024, 2, lds, r, wid, lane);
        else if (r < 112) transpose_tile<1>(a->in[I_MUP] + (size_t)e * 1024 * FFE, FFE, ws + WS_MGU + (size_t)e * 2 * FFE * 1024, 1024, 3, lds, r - 56, wid, lane);
        else transpose_tile<1>(a->in[I_MDOWN] + (size_t)e * FFE * 1024, 1024, ws + WS_MDN + (size_t)e * 1024 * FFE, FFE, 0, lds, r - 112, wid, lane);
    }
    __syncthreads();
}

template <int MODE>
__device__ __forceinline__ void norm_phase(ArgP a, int l, const float* xin, LAS unsigned char* lds_in, int wid_in, int Gx, int Bx, int pm0, int npm, int gsplit = 0) {
    LAS unsigned char* lds = lds_in; int wid = wid_in; asm volatile("" : "+s"(lds), "+s"(wid));
    int lane_ = lane_id(); asm volatile("" : "+v"(lane_));
    const int lane = lane_, tid = wid * 64 + lane;
    unsigned char* ws = a->ws; const int bx = Bx;
    LAS float* TA = (LAS float*)lds; LAS float* TBv = (LAS float*)(lds + 4096);
    LAS float* RW = (LAS float*)(lds + 8192);
    volatile LAS int* RI = (volatile LAS int*)(lds + 8192 + 32768);
    volatile LAS float* RWT = (volatile LAS float*)(lds + 8192 + 32768 + 1024);
    volatile LAS int* LC = (volatile LAS int*)(lds + 8192 + 32768 + 2048);
    const float* mod = (const float*)(ws + WS_MOD);
    const bool from_part = (MODE == 0) && (l == 0);
    const float* modp = (const float*)(ws + WS_MODP);
#define MODV(l_, b_, j_) (from_part ? ({ float s_ = a->in[I_BADA][(l_) * 6144 + (j_)]; _Pragma("unroll") for (int kc_ = 0; kc_ < 8; ++kc_) s_ += modp[((size_t)(kc_ * 2 + (l_)) * 8 + (b_)) * 6144 + (j_)]; s_; }) : mod[((size_t)(l_) * 8 + (b_)) * 6144 + (j_)])
    if (from_part) {
        const int nb_ = npm >> 3, per_ = nb_ * 6144;
        for (int e = bx * NTHREADS + tid; e < 2 * per_; e += Gx * NTHREADS) { const int l2 = e / per_, r2 = e - l2 * per_, b2 = (pm0 >> 3) + r2 / 6144, j2 = r2 % 6144; ((float*)(ws + WS_MOD))[((size_t)l2 * 8 + b2) * 6144 + j2] = MODV(l2, b2, j2); }
    }
    for (int rb = 4 * pm0 + bx; rb < 4 * (pm0 + npm); rb += Gx) {
        const int b = rb >> 5;
        for (int j = tid; j < 1024; j += NTHREADS) {
            float ga, be;
            if (MODE == 0) { ga = a->in[I_ANORM][l * 1024 + j] * (1.f + MODV(l, b, 1024 + j)); be = MODV(l, b, j); }
            else if (MODE == 3) { ga = a->in[I_FINAL][j]; be = 0.f; }
            else { ga = a->in[I_FNORM][l * 1024 + j] * (1.f + mod[((size_t)l * 8 + b) * 6144 + 4096 + j]); be = mod[((size_t)l * 8 + b) * 6144 + 3072 + j]; }
            TA[j] = ga; TBv[j] = be;
        }
        if (MODE == 2) { for (int j = tid; j < 8192; j += NTHREADS) RW[j] = a->in[I_ROUTER][j]; if (tid < 8) LC[tid] = 0; }
        __syncthreads();
#define NORM_LOADROW(dst, row_) do { _Pragma("unroll") for (int j = 0; j < 4; ++j) { \
                if (xin) dst[j] = *(const f32x4*)(xin + (size_t)(row_) * DM + 4 * lane + 256 * j); \
                else { const u32x2 y = *(const u32x2*)((const bf16*)(ws + WS_XR) + (size_t)(row_) * DM + 4 * lane + 256 * j); \
                    dst[j] = (f32x4){__uint_as_float(y.x << 16), __uint_as_float(y.x & 0xFFFF0000u), __uint_as_float(y.y << 16), __uint_as_float(y.y & 0xFFFF0000u)}; } \
                if (MODE == 3) { const u32x2 y = *(const u32x2*)((const bf16*)(ws + WS_Y1) + (size_t)(row_) * DM + 4 * lane + 256 * j); \
                    dst[j][0] += __uint_as_float(y.x << 16); dst[j][1] += __uint_as_float(y.x & 0xFFFF0000u); dst[j][2] += __uint_as_float(y.y << 16); dst[j][3] += __uint_as_float(y.y & 0xFFFF0000u); } } } while (0)
        f32x4 vn[4];
        if (MODE == 2) NORM_LOADROW(vn, rb * 64 + wid * 8);
        f32x4 rwr[(MODE == 2) ? 16 : 1][2];
        if (MODE == 2) {
#pragma unroll
            for (int j = 0; j < 4; ++j)
#pragma unroll
                for (int q = 0; q < 4; ++q) { const LAS f32x4* rw = (const LAS f32x4*)(RW + (size_t)(4 * lane + 256 * j + q) * 8); rwr[j * 4 + q][0] = rw[0]; rwr[j * 4 + q][1] = rw[1]; }
        }
        for (int rr = 0; rr < 8; ++rr) {
            const int rloc = wid * 8 + rr; const int row = rb * 64 + rloc;
            f32x4 v[4]; float s = 0.f;
            if (MODE == 2) {
#pragma unroll
                for (int j = 0; j < 4; ++j) v[j] = vn[j];
                if (rr + 1 < 8) NORM_LOADROW(vn, row + 1);
            } else NORM_LOADROW(v, row);
#pragma unroll
            for (int j = 0; j < 4; ++j) s += (v[j][0] * v[j][0] + v[j][1] * v[j][1]) + (v[j][2] * v[j][2] + v[j][3] * v[j][3]);
            const float rstd = rsqrtf(wave_sum(s) * (1.f / DM) + EPS);
#pragma unroll
            for (int j = 0; j < 4; ++j) { const f32x4 ga = *(const LAS f32x4*)(TA + 4 * lane + 256 * j), be = *(const LAS f32x4*)(TBv + 4 * lane + 256 * j); v[j] = v[j] * rstd * ga + be; }
            if (MODE == 3) {
#pragma unroll
                for (int j = 0; j < 4; ++j) *(f32x4*)(a->out + (size_t)row * DM + 4 * lane + 256 * j) = v[j];
            } else if (MODE == 2) {
                LAS unsigned* rb = (LAS unsigned*)(lds + 49152) + rloc * 256;
#pragma unroll
                for (int j = 0; j < 4; ++j) rb[lane + 64 * j] = pk4_fp8(v[j][0], v[j][1], v[j][2], v[j][3]);
            } else {
                bf16* hrow = (bf16*)(ws + WS_H) + (size_t)row * DM;
#pragma unroll
                for (int j = 0; j < 4; ++j) { u32x2 w; w.x = cvt_pk_bf16(v[j][0], v[j][1]); w.y = cvt_pk_bf16(v[j][2], v[j][3]); *(u32x2*)(hrow + 4 * lane + 256 * j) = w; }
            }
            if (MODE == 0) {
                if (lane < 16) { u32x4 z = (u32x4){0u, 0u, 0u, 0u}; asm volatile("" : "+v"(z)); *(u32x4*)((bf16*)(ws + WS_CQKV) + (size_t)row * 512 + 384 + lane * 8) = z; }
            }
            if (MODE == 2) {
                float lg[8];
#pragma unroll
                for (int e = 0; e < 8; ++e) lg[e] = 0.f;
#pragma unroll
                for (int j = 0; j < 4; ++j)
#pragma unroll
                    for (int q = 0; q < 4; ++q) { const f32x4 w0 = rwr[(MODE == 2) ? j * 4 + q : 0][0], w1 = rwr[(MODE == 2) ? j * 4 + q : 0][1]; const float hv = v[j][q];
                        lg[0] += hv * w0[0]; lg[1] += hv * w0[1]; lg[2] += hv * w0[2]; lg[3] += hv * w0[3]; lg[4] += hv * w1[0]; lg[5] += hv * w1[1]; lg[6] += hv * w1[2]; lg[7] += hv * w1[3]; }
#pragma unroll
                for (int e = 0; e < 8; ++e) lg[e] = wave_sum(lg[e]);
                int e0 = 0; float v0 = lg[0];
#pragma unroll
                for (int e = 1; e < 8; ++e) if (lg[e] > v0) { v0 = lg[e]; e0 = e; }
                int e1 = -1; float v1 = -INFINITY;
#pragma unroll
                for (int e = 0; e < 8; ++e) if (e != e0 && lg[e] > v1) { v1 = lg[e]; e1 = e; }
                const float w1 = frcp(1.f + __expf(v0 - v1)), w0 = 1.f - w1;
                if (lane == 0) { RI[rloc * 4 + 0] = e0; RI[rloc * 4 + 1] = e1; RWT[rloc * 2 + 0] = w0; RWT[rloc * 2 + 1] = w1; }
            }
        }
        if (MODE == 2) {
            __syncthreads();
            if (tid < 64) { const int e0 = RI[tid * 4 + 0], e1 = RI[tid * 4 + 1];
                RI[tid * 4 + 2] = __hip_atomic_fetch_add((LAS int*)&LC[e0], 1, __ATOMIC_RELAXED, __HIP_MEMORY_SCOPE_WORKGROUP);
                RI[tid * 4 + 3] = __hip_atomic_fetch_add((LAS int*)&LC[e1], 1, __ATOMIC_RELAXED, __HIP_MEMORY_SCOPE_WORKGROUP); }
            __syncthreads();
            if (tid < 8) LC[8 + tid] = (int)__hip_atomic_fetch_add((unsigned*)(ws + WS_CTL) + CW_CNT + 64 * tid, (unsigned)LC[tid], RLX_AGENT);
            __syncthreads();
            if (tid < 64) { const int tok = rb * 64 + tid; const int e0 = RI[tid * 4 + 0], e1 = RI[tid * 4 + 1];
                int* perm = (int*)(ws + WS_PERM);
                perm[e0 * T + LC[8 + e0] + RI[tid * 4 + 2]] = tok;
                perm[e1 * T + LC[8 + e1] + RI[tid * 4 + 3]] = tok | (1 << 16);
                ((float*)(ws + WS_TW))[tok * 2 + 0] = RWT[tid * 2 + 0]; ((float*)(ws + WS_TW))[tok * 2 + 1] = RWT[tid * 2 + 1]; }
            if (gsplit) { xcd_barrier_wait((unsigned*)(ws + WS_CTL) + CW_BAR, (volatile LAS unsigned*)(lds + MISC_OFF), wid); gsplit = 0; }
            for (int q = tid; q < 64 * 2 * 64; q += NTHREADS) {
                const int ch = q & 63, sl = (q >> 6) & 1, r = q >> 7;
                const int e = RI[r * 4 + sl], pos = LC[8 + e] + RI[r * 4 + 2 + sl];
                const u32x4 vv = *(const LAS u32x4*)(lds + 49152 + r * 1024 + ch * 16);
                *(u32x4*)((fp8*)(ws + WS_HS8) + ((size_t)e * T + pos) * DM + ch * 16) = vv;
            }
        }
        __syncthreads();
    }
    if (gsplit) xcd_barrier_wait((unsigned*)(ws + WS_CTL) + CW_BAR, (volatile LAS unsigned*)(lds + MISC_OFF), wid);
}

__device__ __forceinline__ void norm1_l0_split(ArgP a, LAS unsigned char* lds_in, int wid_in, int Gx, int Bx, int pm0, int npm) {
    LAS unsigned char* lds = lds_in; int wid = wid_in; asm volatile("" : "+s"(lds), "+s"(wid));
    int lane_ = lane_id(); asm volatile("" : "+v"(lane_));
    const int lane = lane_, tid = wid * 64 + lane;
    unsigned char* ws = a->ws; const int bx = Bx;
    LAS float* TA = (LAS float*)lds; LAS float* TBv = (LAS float*)(lds + 4096);
    const int rb = 4 * pm0 + bx, b = rb >> 5, row0 = rb * 64 + wid * 8;
    const float* xin = a->in[I_X];
    f32x4 v[8][4]; float rstd[8];
#pragma unroll
    for (int rr = 0; rr < 8; ++rr)
#pragma unroll
        for (int j = 0; j < 4; ++j) v[rr][j] = *(const f32x4*)(xin + (size_t)(row0 + rr) * DM + 4 * lane + 256 * j);
#pragma unroll
    for (int rr = 0; rr < 8; ++rr) { float s = 0.f;
#pragma unroll
        for (int j = 0; j < 4; ++j) s += (v[rr][j][0] * v[rr][j][0] + v[rr][j][1] * v[rr][j][1]) + (v[rr][j][2] * v[rr][j][2] + v[rr][j][3] * v[rr][j][3]);
        rstd[rr] = rsqrtf(wave_sum(s) * (1.f / DM) + EPS); }
    xcd_barrier_wait((unsigned*)(ws + WS_CTL) + CW_BAR, (volatile LAS unsigned*)(lds + MISC_OFF), wid);
    const float* modp = (const float*)(ws + WS_MODP);
#define MODV0(l_, b_, j_) ({ float s_ = a->in[I_BADA][(l_) * 6144 + (j_)]; _Pragma("unroll") for (int kc_ = 0; kc_ < 8; ++kc_) s_ += modp[((size_t)(kc_ * 2 + (l_)) * 8 + (b_)) * 6144 + (j_)]; s_; })
    { const int nb_ = npm >> 3, per_ = nb_ * 6144;
      for (int e = bx * NTHREADS + tid; e < 2 * per_; e += Gx * NTHREADS) { const int l2 = e / per_, r2 = e - l2 * per_, b2 = (pm0 >> 3) + r2 / 6144, j2 = r2 % 6144; ((float*)(ws + WS_MOD))[((size_t)l2 * 8 + b2) * 6144 + j2] = MODV0(l2, b2, j2); } }
    for (int j = tid; j < 1024; j += NTHREADS) { TA[j] = a->in[I_ANORM][j] * (1.f + MODV0(0, b, 1024 + j)); TBv[j] = MODV0(0, b, j); }
#undef MODV0
    __syncthreads();
#pragma unroll
    for (int rr = 0; rr < 8; ++rr) {
        const int row = row0 + rr;
        bf16* hrow = (bf16*)(ws + WS_H) + (size_t)row * DM;
#pragma unroll
        for (int j = 0; j < 4; ++j) { const f32x4 ga = *(const LAS f32x4*)(TA + 4 * lane + 256 * j), be = *(const LAS f32x4*)(TBv + 4 * lane + 256 * j); const f32x4 o = v[rr][j] * rstd[rr] * ga + be;
            u32x2 w; w.x = cvt_pk_bf16(o[0], o[1]); w.y = cvt_pk_bf16(o[2], o[3]); *(u32x2*)(hrow + 4 * lane + 256 * j) = w; }
        if (lane < 16) { u32x4 z = (u32x4){0u, 0u, 0u, 0u}; asm volatile("" : "+v"(z)); *(u32x4*)((bf16*)(ws + WS_CQKV) + (size_t)row * 512 + 384 + lane * 8) = z; }
    }
    __syncthreads();
}

__device__ __forceinline__ void up_misc(ArgP a, int l, LAS unsigned char* lds_in, int wid_in, int Gx, int Bx, int pm0, int npm) {
    LAS unsigned char* lds = lds_in; int wid = wid_in; asm volatile("" : "+s"(wid), "+s"(lds));
    int lane_ = lane_id(); asm volatile("" : "+v"(lane_));
    const int lane = lane_, tid = wid * 64 + lane;
    unsigned char* ws = a->ws; const float* misc = (const float*)(ws + WS_MISC);
    const int sb0 = (Gx / 2 + 6 * (npm >> 3) <= Gx) ? Gx / 2 : 0;
    if (Bx >= sb0 && Bx < sb0 + 6 * (npm >> 3)) {
        const int bxs = Bx - sb0; const int b = (pm0 >> 3) + bxs / 6, h = bxs % 6; const float bf = a->in[I_BFORGET][l * 6 + h];
        float c[4]; float run = 0.f;
#pragma unroll
        for (int i = 0; i < 4; ++i) { const float z = misc[(size_t)(b * SEQ + 4 * tid + i) * 64 + 32 + h] + bf;
            const float ls = fminf(z, 0.f) - 0.6931471805599453f * __builtin_amdgcn_logf(1.f + fexp2(-fabsf(z) * LOG2E)); run += ls; c[i] = run; }
        float inc = run;
#pragma unroll
        for (int o = 1; o < 64; o <<= 1) { const int ln = lane_id(); const float t = __uint_as_float((unsigned)__builtin_amdgcn_ds_bpermute(((ln - o) & 63) << 2, (int)__float_as_uint(inc))); if (ln >= o) inc += t; }
        volatile LAS float* wt = (volatile LAS float*)(lds + MISC_OFF + 4096);
        if (lane == 63) wt[wid] = inc;
        __syncthreads();
        float off = inc - run;
#pragma unroll
        for (int w = 0; w < 8; ++w) off += (w < wid) ? wt[w] : 0.f;
        bf16* fk = (bf16*)(ws + WS_FK2) + ((size_t)(b * SEQ + 4 * tid)) * 480 + h * 80 + 64;
#pragma unroll
        for (int i = 0; i < 4; ++i) {
            const float nf = -(off + c[i]) * LOG2E;
            const unsigned h1 = cvt_pk_bf16(nf, 0.f) & 0xFFFFu; const float r1 = nf - __uint_as_float(h1 << 16);
            const unsigned h2 = cvt_pk_bf16(r1, 0.f) & 0xFFFFu; const float r2 = r1 - __uint_as_float(h2 << 16);
            const unsigned h3 = cvt_pk_bf16(r2, 0.f) & 0xFFFFu;
            u32x4 w0 = zero4u_asm(); w0.x = h1 | (h2 << 16); w0.y = h3;
            *(u32x4*)(fk + (size_t)i * 480) = w0; *(u32x4*)(fk + (size_t)i * 480 + 8) = zero4u_asm();
        }
        __syncthreads();
    }
    const float* cosT = (const float*)(ws + WS_COS); const float* sinT = (const float*)(ws + WS_SIN);
    bf16* mk = (bf16*)(ws + WS_MK);
    for (int idx = pm0 * 1024 + Bx * NTHREADS + tid; idx < (pm0 + npm) * 1024; idx += Gx * NTHREADS) {
        const int t = idx >> 2, q = idx & 3, i0 = (q & 1) * 8, pos = t & (SEQ - 1);
        const float* mr = misc + (size_t)t * 64 + i0;
        const f32x4 xa0 = *(const f32x4*)mr, xa1 = *(const f32x4*)(mr + 4), xb0 = *(const f32x4*)(mr + 16), xb1 = *(const f32x4*)(mr + 20);
        const f32x4 c0 = *(const f32x4*)(cosT + pos * 16 + i0), c1 = *(const f32x4*)(cosT + pos * 16 + i0 + 4), s0 = *(const f32x4*)(sinT + pos * 16 + i0), s1 = *(const f32x4*)(sinT + pos * 16 + i0 + 4);
        const f32x4 o0 = (q < 2) ? (xa0 * c0 - xb0 * s0) : (xa0 * s0 + xb0 * c0), o1 = (q < 2) ? (xa1 * c1 - xb1 * s1) : (xa1 * s1 + xb1 * c1);
        u32x4 w; w.x = cvt_pk_bf16(o0[0], o0[1]); w.y = cvt_pk_bf16(o0[2], o0[3]); w.z = cvt_pk_bf16(o1[0], o1[1]); w.w = cvt_pk_bf16(o1[2], o1[3]);
#pragma unroll
        for (int h = 0; h < 6; ++h) *(u32x4*)(mk + (size_t)t * 576 + h * 96 + 64 + q * 8) = w;
    }
}

#ifndef CONV_QUOTA
#define CONV_QUOTA 3
#endif
#define PHASE_PRE() ArgP a = argp(); int Gl = Gx, Bl = Bx; asm volatile("" : "+s"(Gl), "+s"(Bl)); unsigned char* ws = a->ws; (void)ws
#define SLICE_ARGS int Gx, int Bx, int pm0_in, int npm_in, int loc_in
#define SLICE_PRE() PHASE_PRE(); int pm0 = pm0_in, npm = npm_in, loc = loc_in; asm volatile("" : "+s"(pm0), "+s"(npm), "+s"(loc))
__device__ __forceinline__ void ph_norm1(int l, LAS unsigned char* lds, int wid, SLICE_ARGS) { SLICE_PRE(); (void)loc; norm_phase<0>(a, l, (l == 0) ? a->in[I_X] : nullptr, lds, wid, Gl, Bl, pm0, npm); }
__device__ __forceinline__ void ph_inproj(int l, LAS unsigned char* lds, int wid, SLICE_ARGS) {
    SLICE_PRE();
    pg8::Gemm g{ws + WS_H, (const bf16*)(ws + WS_WIN) + (size_t)l * NIN * 1024, 16, 2048, 2048, nullptr};
    pg8::StaticOrder S; S.init(npm, pm0, NIN, Gl, Bl, loc);
    EpiSplit<0> E{ws, nullptr};
    pg8::gemm_phase<EpiSplit<0>, pg8::StaticOrder, false>(lds, g, S, E, wid);
    if (2 * Bl >= Gl) moe_convert(a, lds, wid, CONV_QUOTA);
}
__device__ __forceinline__ void ph_up(int l, LAS unsigned char* lds, int wid, SLICE_ARGS) {
    SLICE_PRE(); (void)loc;
    up_misc(a, l, lds, wid, Gl, Bl, pm0, npm);
    pg8::Gemm g{ws + WS_CQKV, (const bf16*)(ws + WS_WUP) + (size_t)l * 1536 * 256, 4, 1024, 512, nullptr};
    UpOrder S{Gl, Bl, pm0, npm};
    LAS float* rsl = (LAS float*)(lds + MISC_OFF + 8192);
    { const int tid_ = wid * 64 + lane_id();
      if (tid_ < 256 && Bl < npm * 6) { const int pn_ = Bl / npm, pm_ = pm0 + (Bl - pn_ * npm); const float* rp = (const float*)(ws + WS_SSP) + (size_t)(pm_ * 256 + tid_) * 12;
          const f32x4 p0 = *(const f32x4*)rp, p1 = *(const f32x4*)(rp + 4), p2 = *(const f32x4*)(rp + 8);
          const float qs = ((p0[0] + p0[1]) + (p0[2] + p0[3])) + ((p1[0] + p1[1]) + (p1[2] + p1[3])), ks = (p2[0] + p2[1]) + (p2[2] + p2[3]);
          rsl[tid_ * 2] = rsqrtf(qs * (1.f / 256.f) + EPS); rsl[tid_ * 2 + 1] = rsqrtf(ks * (1.f / 128.f) + EPS); }
      __syncthreads(); }
    EpiSplit<1> E{ws, rsl};
    pg8::gemm_phase<EpiSplit<1>, UpOrder, false>(lds, g, S, E, wid);
}
#ifndef ATT_MASK
#define ATT_MASK 7
#endif
__device__ __forceinline__ void ph_attn(int l, int rep, LAS unsigned char* lds, int wid, int loc_in, int xq_in, int split_in) {
    int loc = loc_in, xq = xq_in, waited = split_in ? 0 : 1; asm volatile("" : "+s"(loc), "+s"(xq), "+s"(waited));
    for (;;) {
        ArgP a = argp(); unsigned char* ws = a->ws;
        LAS unsigned char* lp = lds; asm volatile("" : "+s"(lp));
        volatile LAS unsigned* mq = (volatile LAS unsigned*)(lp + MISC_OFF);
        if (wid == 0 && lane_id() == 0) mq[4] = __hip_atomic_fetch_add((unsigned*)(ws + WS_CTL) + CW_ATTQ + 64 * (l + 2 * rep) + (loc ? 4 + 4 * xq : 0), 1u, RLX_AGENT);
        __syncthreads();
        const int u = __builtin_amdgcn_readfirstlane((int)mq[4]);
        if (u >= (loc ? 160 : 1024)) break;
        if (loc && u >= 128) {
            if (!waited) { xcd_local_wait((unsigned*)(ws + WS_CTL) + CW_BAR, mq, wid); waited = 1; }
            const int j = u - 128, p = 7 - (j >> 2), pnt = j & 3;
            unsigned* pc = (unsigned*)(ws + WS_CTL) + CW_PANEL + (((l + 2 * rep) * 8 + xq) * 8 + p) * 16;
            if (wid == 0 && lane_id() == 0) { XB_SPIN(xb_ld(pc) < 16u, (unsigned*)(ws + WS_CTL) + CW_BAR); __builtin_amdgcn_fence(__ATOMIC_ACQUIRE, "agent"); asm volatile("s_waitcnt vmcnt(0)" ::: "memory"); }
            __syncthreads();
            pg8::Gemm g{ws + WS_MERGED, (const bf16*)(ws + WS_WOUT) + (size_t)l * 1024 * 1024, 16, 2048, 2048, nullptr};
            const int row0 = (8 * xq + p) * 256;
            OneUnit S{{row0, 0, pnt * 256, row0, pnt, 256, 0}};
            EpiResid E{(l == 0) ? a->in[I_X] : nullptr, (const bf16*)(ws + WS_XR), (bf16*)(ws + WS_XR), (const float*)(ws + WS_MOD) + (size_t)l * 8 * 6144 + 2048};
            pg8::gemm_phase<EpiResid, OneUnit, false>(lds, g, S, E, wid);
            continue;
        }
        int type, qb, b, h;
        if (loc) { att::decode_unit_local(u, type, qb, h); b = xq; } else att::decode_unit(u, type, qb, b, h);
        type = __builtin_amdgcn_readfirstlane(type); qb = __builtin_amdgcn_readfirstlane(qb); b = __builtin_amdgcn_readfirstlane(b); h = __builtin_amdgcn_readfirstlane(h);
        if (!waited && type != 0) { xcd_local_wait((unsigned*)(ws + WS_CTL) + CW_BAR, mq, wid); waited = 1; }
#if defined(ATT_REP_TYPE)
        if (rep && !(type == ATT_REP_TYPE && qb >= ATT_REP_QBMIN && qb <= ATT_REP_QBMAX)) continue;
#endif
        if ((ATT_MASK & 1) && type == 0) {
            att::Tensors TD{(const bf16*)(ws + WS_DQ), (const bf16*)(ws + WS_DK), (const bf16*)(ws + WS_DV), 256, 256, 256, 64, 64, (bf16*)(ws + WS_MERGED), 0,
                            nullptr, a->in[I_RELB], a->in[I_DLAM] + l * 128, a->in[I_SUBLN] + l * 64, (l == 0) ? 0.2f : 0.35550906759096934f};
            att::attn_unit<0>(TD, b, h, qb, lds, wid);
        } else if ((ATT_MASK & 2) && type == 1) {
            att::Tensors TF{(const bf16*)(ws + WS_FQ), (const bf16*)(ws + WS_FK2), (const bf16*)(ws + WS_FV), 384, 480, 384, 64, 80, (bf16*)(ws + WS_MERGED), 256,
                            (const float*)(ws + WS_FB), nullptr, nullptr, nullptr, 0.f};
            att::attn_unit<1>(TF, b, h, qb, lds, wid);
        } else if ((ATT_MASK & 4) && type == 2) {
            att::Tensors TM{(const bf16*)(ws + WS_MQ), (const bf16*)(ws + WS_MK), (const bf16*)(ws + WS_MV), 576, 576, 384, 96, 96, (bf16*)(ws + WS_MERGED), 640,
                            nullptr, nullptr, nullptr, nullptr, 0.f};
            att::attn_unit<2>(TM, b, h, qb, lds, wid);
        }
        if (loc) {
            asm volatile("s_waitcnt vmcnt(0)" ::: "memory");
            __syncthreads();
            if (wid == 0 && lane_id() == 0) xb_add((unsigned*)(ws + WS_CTL) + CW_PANEL + (((l + 2 * rep) * 8 + xq) * 8 + qb) * 16, 1u);
        }
    }
    if (!waited) { ArgP a = argp(); LAS unsigned char* lp = lds; asm volatile("" : "+s"(lp)); xcd_local_wait((unsigned*)(a->ws + WS_CTL) + CW_BAR, (volatile LAS unsigned*)(lp + MISC_OFF), wid); }
}
__device__ __forceinline__ void ph_outproj(int l, LAS unsigned char* lds, int wid, SLICE_ARGS) {
    SLICE_PRE();
    pg8::Gemm g{ws + WS_MERGED, (const bf16*)(ws + WS_WOUT) + (size_t)l * 1024 * 1024, 16, 2048, 2048, nullptr};
    pg8::StaticOrder S; S.init(npm, pm0, DM, Gl, Bl, loc);
    EpiResid E{(l == 0) ? a->in[I_X] : nullptr, (const bf16*)(ws + WS_XR), (bf16*)(ws + WS_XR), (const float*)(ws + WS_MOD) + (size_t)l * 8 * 6144 + 2048};
    pg8::gemm_phase<EpiResid, pg8::StaticOrder, false>(lds, g, S, E, wid);
}
__device__ __forceinline__ void ph_gu_dense(int l, LAS unsigned char* lds, int wid, SLICE_ARGS) {
    SLICE_PRE();
    pg8::Gemm g{ws + WS_H, ws + WS_WGU, 16, 2048, 2048, nullptr};
    pg8::StaticOrder S; S.init(npm, pm0, 2 * FFD, Gl, Bl, loc);
    EpiGU E{(bf16*)(ws + WS_ACT), FFD};
    pg8::gemm_phase<EpiGU, pg8::StaticOrder, false>(lds, g, S, E, wid);
    if (2 * Bl >= Gl) moe_convert(a, lds, wid, CONV_QUOTA);
}
__device__ __forceinline__ void ph_down_dense(int l, LAS unsigned char* lds, int wid, SLICE_ARGS) {
    SLICE_PRE();
    pg8::Gemm g{ws + WS_ACT, ws + WS_WDN, FFD / 64, FFD * 2, FFD * 2, nullptr};
    pg8::StaticOrder S; S.init(npm, pm0, DM, Gl, Bl, loc);
    EpiResid E{nullptr, (const bf16*)(ws + WS_XR), (bf16*)(ws + WS_XR), (const float*)(ws + WS_MOD) + (size_t)l * 8 * 6144 + 5120};
    pg8::gemm_phase<EpiResid, pg8::StaticOrder, false>(lds, g, S, E, wid);
}
__device__ __forceinline__ void ph_gu_moe(int l, LAS unsigned char* lds, int wid, int Gx, int Bx) {
    PHASE_PRE();
    LAS unsigned char* lp = lds; asm volatile("" : "+s"(lp));
    volatile LAS int* tab = (volatile LAS int*)(lp + MISC_OFF + 64);
    moe_tables(tab, (const unsigned*)(ws + WS_CTL) + CW_CNT, 2 * FFE / 256, wid);
    pg8::Gemm g{ws + WS_HS8, ws + WS_MGU, 8, 1024, 1024, nullptr};
    MoeOrder S{tab, Gl, Bl, 2 * FFE / 256, 0, 1 << 30};
    EpiGU8 E{(fp8*)(ws + WS_ACT8), FFE};
    pg8::gemm_phase<EpiGU8, MoeOrder, false, true>(lds, g, S, E, wid);
}
__device__ __forceinline__ void ph_down_moe(int l, LAS unsigned char* lds, int wid, int Gx, int Bx) {
    PHASE_PRE();
    LAS unsigned char* lp = lds; asm volatile("" : "+s"(lp));
    volatile LAS int* tab = (volatile LAS int*)(lp + MISC_OFF + 64);
    moe_tables(tab, (const unsigned*)(ws + WS_CTL) + CW_CNT, DM / 256, wid);
    pg8::Gemm g{ws + WS_ACT8, ws + WS_MDN, FFE / 128, FFE, FFE, nullptr};
    const int lim = 2 * Gl;
    MoeOrder S{tab, Gl, Bl, DM / 256, 1, lim};
    EpiMoeDown E{(bf16*)(ws + WS_XR), (bf16*)(ws + WS_Y1), (const float*)(ws + WS_MOD) + (size_t)l * 8 * 6144 + 5120, (const int*)(ws + WS_PERM), (const float*)(ws + WS_TW)};
    pg8::gemm_phase<EpiMoeDown, MoeOrder, false, true>(lds, g, S, E, wid);
    MoeOrder S2{tab, Gl, Bl, DM / 256, 2, lim};
    EpiMoeDownT<1> E2{E.x, E.y1, E.gate, E.perm, E.tw};
    pg8::gemm_phase<EpiMoeDownT<1>, MoeOrder, false, true, 1>(lds, g, S2, E2, wid);
}

constexpr int NPHASE = 18;
#ifndef PH_MASK
#define PH_MASK 0x3FFFF
#endif
#ifndef BISECT_GLOBAL_SEAMS
#define BISECT_GLOBAL_SEAMS 0
#endif
#ifndef LOCAL_MODE
#define LOCAL_MODE 1
#endif
#ifndef REP_MASK
#define REP_MASK 0
#endif
__global__ void __launch_bounds__(NTHREADS, 2) fwd_kernel(Args a_by_value_unused) {
    extern __shared__ __attribute__((aligned(16))) unsigned char lds_raw[];
    LAS unsigned char* lds = (LAS unsigned char*)lds_raw;
    volatile LAS unsigned* MISC0 = (volatile LAS unsigned*)(lds + MISC_OFF);
#define MISC (__extension__({ LAS unsigned char* p_ = lds; asm volatile("" : "+s"(p_)); (volatile LAS unsigned*)(p_ + MISC_OFF); }))
    const int Gx = grid_n(), Bx = block_i();
    const int wid = __builtin_amdgcn_readfirstlane((int)(threadIdx.x >> 6));
    {
        const int lane0 = lane_id();
        for (int u = wid * 64 + lane0; u < (LDS_BYTES - MISC_OFF) / 4; u += NTHREADS) MISC0[u] = 0u;
        __syncthreads();
    }
#if MK_MULTI
    const int lo = argp()->ph_lo, hi = argp()->ph_hi;
#define IN(k) (((PH_MASK >> (k)) & 1) && lo <= (k) && (k) < hi)
#define SEAM(k) do { } while (0)
#define SEAMX() do { } while (0)
#else
    xcd_barrier_post((unsigned*)(argp()->ws + WS_CTL) + CW_BAR, wid, MISC0);
#define IN(k) ((PH_MASK >> (k)) & 1)
#define SEAM(k) do { xcd_barrier((unsigned*)(argp()->ws + WS_CTL) + CW_BAR, MISC, wid); } while (0)
#define SEAMX() xcd_barrier((unsigned*)(argp()->ws + WS_CTL) + CW_BAR, MISC, wid)
#endif
#if MK_MULTI
#define SEAML(k) do { } while (0)
#else
#define SEAML(k) do { if (loc && !(BISECT_GLOBAL_SEAMS)) xcd_local_barrier((unsigned*)(argp()->ws + WS_CTL) + CW_BAR, MISC, wid); else xcd_barrier((unsigned*)(argp()->ws + WS_CTL) + CW_BAR, MISC, wid); } while (0)
#endif
#define REP(k) (((REP_MASK) >> (k)) & 1)

    if (IN(0)) { prologue(argp(), lds, wid, Gx, Bx); }
    if (REP(0)) { SEAMX(); prologue(argp(), lds, wid, Gx, Bx); }
    int loc = 0, Gs = Gx, Bs = Bx, pm0s = 0, npms = T / 256, xq = 0, norm_done0 = 0;
#if !MK_MULTI && LOCAL_MODE && (REP_MASK) == 0
    xcd_barrier_arrive((unsigned*)(argp()->ws + WS_CTL) + CW_BAR, MISC, wid);
    __syncthreads();
    { volatile LAS unsigned* m_ = MISC;
      if (__builtin_amdgcn_readfirstlane((int)m_[2]) != 0) { loc = 1; xq = (int)(xb_xcc_id() & 7u); Gs = __builtin_amdgcn_readfirstlane((int)m_[0]); Bs = __builtin_amdgcn_readfirstlane((int)m_[3]); pm0s = 8 * xq; npms = 8; } }
    if (loc && Gs == 32 && IN(1)) { norm1_l0_split(argp(), lds, wid, Gs, Bs, pm0s, npms); norm_done0 = 1; }
    else xcd_barrier_wait((unsigned*)(argp()->ws + WS_CTL) + CW_BAR, MISC, wid);
#else
    SEAM(0);
#endif
#define SLICE Gs, Bs, pm0s, npms, loc
#define WHOLE Gx, Bx, 0, T / 256, 0
    for (int l = 0; l < DEPTH; ++l) {
        const int pb = 1 + 8 * l;
        if (IN(pb + 0) && !(l == 0 && norm_done0)) ph_norm1(l, lds, wid, SLICE);
        if (REP(pb + 0)) { SEAMX(); ph_norm1(l, lds, wid, WHOLE); }
        SEAML(pb + 0);
        if (IN(pb + 1)) ph_inproj(l, lds, wid, SLICE);
        if (REP(pb + 1)) { SEAMX(); ph_norm1(l, lds, wid, WHOLE); SEAMX(); ph_inproj(l, lds, wid, WHOLE); }
        SEAML(pb + 1);
        if (IN(pb + 2)) ph_up(l, lds, wid, SLICE);
        if (REP(pb + 2)) { SEAMX(); ph_up(l, lds, wid, WHOLE); }
        if (loc) xcd_local_arrive((unsigned*)(argp()->ws + WS_CTL) + CW_BAR, MISC, wid); else SEAM(pb + 2);
        if (IN(pb + 3)) ph_attn(l, 0, lds, wid, loc, xq, loc);
        if (REP(pb + 3)) { SEAMX(); ph_attn(l, 1, lds, wid, 0, 0, 0); }
        if (!loc) { SEAM(pb + 3); if (IN(pb + 4)) ph_outproj(l, lds, wid, SLICE); }
        if (REP(pb + 4) && l == 0) { SEAMX(); ph_outproj(l, lds, wid, WHOLE); }
        if (l == DEPTH - 1 && IN(pb + 4)) { PHASE_PRE(); (void)Gl; (void)Bl; moe_convert(a, lds, wid, 1 << 20); }
        if (l == DEPTH - 1) { if (loc) { xcd_local_barrier((unsigned*)(argp()->ws + WS_CTL) + CW_BAR, MISC, wid); xcd_barrier_arrive((unsigned*)(argp()->ws + WS_CTL) + CW_BAR, MISC, wid); } else SEAM(pb + 4); }
        else SEAML(pb + 4);
        if (l == 0) {
            if (IN(pb + 5)) { PHASE_PRE(); norm_phase<1>(a, l, nullptr, lds, wid, Gs, Bs, pm0s, npms); (void)Gl; (void)Bl; }
            if (REP(pb + 5)) { SEAMX(); PHASE_PRE(); norm_phase<1>(a, l, nullptr, lds, wid, Gl, Bl, 0, T / 256); }
            SEAML(pb + 5);
            if (IN(pb + 6)) ph_gu_dense(l, lds, wid, SLICE);
            if (REP(pb + 6)) { SEAMX(); ph_gu_dense(l, lds, wid, WHOLE); }
            SEAML(pb + 6);
            if (IN(pb + 7)) ph_down_dense(l, lds, wid, SLICE);
            SEAML(pb + 7);
        } else {
            if (IN(pb + 5)) { PHASE_PRE(); norm_phase<2>(a, l, nullptr, lds, wid, Gs, Bs, pm0s, npms, loc); (void)Gl; (void)Bl; }
            SEAM(pb + 5);
            const int Bm = loc ? xq * Gs + Bs : Bx;
            if (IN(pb + 6)) ph_gu_moe(l, lds, wid, Gx, Bm);
            if (REP(pb + 6)) { SEAMX(); ph_gu_moe(l, lds, wid, Gx, Bx); }
            SEAM(pb + 6);
            if (IN(pb + 7)) ph_down_moe(l, lds, wid, Gx, Bm);
            SEAM(pb + 7);
        }
    }
    if (IN(17)) { PHASE_PRE(); norm_phase<3>(a, 0, nullptr, lds, wid, Gl, Bl, 0, T / 256); }
#undef SLICE
#undef WHOLE
#undef SEAML
#undef IN
#undef SEAM
#undef SEAMX
#undef REP
#undef MISC
}

extern "C" void kernel_launch(void* const* d_in, const int* in_sizes, int n_in, void* d_out, int out_size, void* d_ws, size_t ws_size, hipStream_t stream) {
    static int grid = 0;
    if (grid == 0) {
        if (n_in != 24 || out_size != T * DM || ws_size < WS_END) { fprintf(stderr, "kernel_launch: unexpected shapes (n_in %d, out %d, ws %zu)\n", n_in, out_size, ws_size); grid = -1; return; }
        int dev = 0, cus = 0;
        if (hipGetDevice(&dev) != hipSuccess || hipDeviceGetAttribute(&cus, hipDeviceAttributeMultiprocessorCount, dev) != hipSuccess) { grid = -1; return; }
        if (hipFuncSetAttribute((const void*)fwd_kernel, hipFuncAttributeMaxDynamicSharedMemorySize, LDS_BYTES) != hipSuccess) { fprintf(stderr, "kernel_launch: hipFuncSetAttribute failed\n"); grid = -1; return; }
        int per_cu = 0;
        if (hipOccupancyMaxActiveBlocksPerMultiprocessor(&per_cu, (const void*)fwd_kernel, NTHREADS, LDS_BYTES) != hipSuccess || per_cu < 1) fprintf(stderr, "kernel_launch: occupancy query reports %d\n", per_cu);
        (void)hipGetLastError();
        grid = cus;
    }
    if (grid < 0) return;
    if (hipMemsetAsync((char*)d_ws + WS_CTL, 0, CTL_ZERO_BYTES, stream) != hipSuccess) return;
    Args a{};
    for (int i = 0; i < 24; ++i) a.in[i] = (const float*)d_in[i];
    a.out = (float*)d_out; a.ws = (unsigned char*)d_ws;
#if MK_MULTI
    for (int ph = 0; ph < NPHASE; ++ph) { a.ph_lo = ph; a.ph_hi = ph + 1; hipLaunchKernelGGL(fwd_kernel, dim3(grid), dim3(NTHREADS), LDS_BYTES, stream, a); }
#else
    a.ph_lo = 0; a.ph_hi = NPHASE;
    hipLaunchKernelGGL(fwd_kernel, dim3(grid), dim3(NTHREADS), LDS_BYTES, stream, a);
#endif
}
```
